# Optimizing an MI355X kernel written in HIP

```python
import jax, jax.numpy as jnp
from jax import lax
import numpy as np

D_MODEL = 1024
BATCH = 32
SEQ = 256
DEPTH = 2
DEC_BATCH = 4
DEC_SEQ = 1024
PAST_LEN = 512

GRID_W = 64
HEAD_DIM = 64
N_HEADS = D_MODEL // HEAD_DIM
KV_HEADS = N_HEADS // 4
ATT_WIDTH = N_HEADS * HEAD_DIM
KV_WIDTH = KV_HEADS * HEAD_DIM
ROPE_FREQS = HEAD_DIM // 4
ROPE_THETA = 10000.0
Q_BLOCK = 128
GLA_HEADS = 4
GLA_DK = D_MODEL // 2 // GLA_HEADS
GLA_DV = D_MODEL // GLA_HEADS
GLA_QK_WIDTH = GLA_HEADS * GLA_DK
GLA_V_WIDTH = GLA_HEADS * GLA_DV
GATE_RANK = 16
GATE_NORM = 16.0
GLA_CHUNK = 64
N_KEYS = 128
N_EXPERTS = N_KEYS * N_KEYS
PEER_HEADS = 8
PEER_TOPK = 16
PEER_QDIM = 256
PEER_HALF = PEER_QDIM // 2
PEER_BLOCK = 128
ALPHA = (2.0 * DEPTH) ** 0.25
BETA = (8.0 * DEPTH) ** -0.25
LN_EPS = 1e-5
RMS_EPS = 1e-6
IN_SIZES = (ATT_WIDTH, KV_WIDTH, KV_WIDTH, GLA_QK_WIDTH, GLA_QK_WIDTH, GLA_V_WIDTH, GLA_V_WIDTH, 2 * GATE_RANK, 2 * D_MODEL)
IN_SPLITS = tuple(int(s) for s in np.cumsum(IN_SIZES)[:-1])
IN_WIDTH = int(sum(IN_SIZES))

kernel_name = 'hybrid_diffusion_gqa_gla_peer_step'


def rms_norm(x, g):
    xf = x.astype(jnp.float32)
    out = xf * lax.rsqrt(jnp.mean(xf * xf, axis=-1, keepdims=True) + RMS_EPS)
    return out.astype(x.dtype) * g


def layer_norm(x, g, b):
    xf = x.astype(jnp.float32)
    mu = jnp.mean(xf, axis=-1, keepdims=True)
    var = jnp.mean(jnp.square(xf - mu), axis=-1, keepdims=True)
    return ((xf - mu) * lax.rsqrt(var + LN_EPS)).astype(x.dtype) * g + b


def axial_rope(L, dtype):
    rows = L // GRID_W
    r = jnp.repeat(jnp.arange(rows, dtype=jnp.float32), GRID_W)
    col = jnp.tile(jnp.arange(GRID_W, dtype=jnp.float32), rows)
    inv = ROPE_THETA ** (-jnp.arange(ROPE_FREQS, dtype=jnp.float32) / ROPE_FREQS)
    ang = jnp.stack([r[:, None] * inv, col[:, None] * inv], axis=1)
    return jnp.cos(ang).astype(dtype), jnp.sin(ang).astype(dtype)


def apply_rope(x, cos, sin):
    B, L, H, _ = x.shape
    xr = x.reshape(B, L, H, 2, 2, ROPE_FREQS)
    x1, x2 = xr[..., 0, :], xr[..., 1, :]
    c, s = cos[None, :, None], sin[None, :, None]
    out = jnp.stack([x1 * c - x2 * s, x2 * c + x1 * s], axis=-2)
    return out.reshape(B, L, H, HEAD_DIM)


def gqa_attend(q, k, v):
    B, Lq, H, D = q.shape
    G = k.shape[2]
    R = H // G
    nb = Lq // Q_BLOCK
    qb = q.reshape(B, nb, Q_BLOCK, G, R, D).transpose(1, 0, 2, 3, 4, 5)

    def one_block(qblk):
        s = jnp.einsum('bqgrd,bkgd->bgrqk', qblk, k).astype(jnp.float32) * (D ** -0.5)
        p = jax.nn.softmax(s, axis=-1).astype(v.dtype)
        return jnp.einsum('bgrqk,bkgd->bqgrd', p, v)

    o = lax.map(one_block, qb)
    return o.transpose(1, 0, 2, 3, 4, 5).reshape(B, Lq, H * D)


def gla_scan(q, k, v, log_a, s0):
    B, L, H, _ = q.shape
    DV = v.shape[-1]
    n = L // GLA_CHUNK

    def chunks(t):
        return t.astype(jnp.float32).reshape(B, n, GLA_CHUNK, H, -1).transpose(1, 0, 3, 2, 4)

    qc, kc, vc, ac = chunks(q), chunks(k), chunks(v), chunks(log_a)
    bc = jnp.cumsum(ac, axis=3)
    mask = jnp.tril(jnp.ones((GLA_CHUNK, GLA_CHUNK), dtype=bool))

    def step(S, inp):
        qi, ki, vi, bi = inp
        bl = bi[:, :, -1:, :]
        q_e = qi * jnp.exp(bi)
        k_e = ki * jnp.exp(-bi)
        A = jnp.where(mask, jnp.einsum('bhid,bhjd->bhij', q_e, k_e), 0.0)
        o = jnp.einsum('bhij,bhjv->bhiv', A, vi) + jnp.einsum('bhid,bhdv->bhiv', q_e, S)
        S_new = jnp.exp(bl[:, :, 0, :])[..., None] * S + jnp.einsum('bhjd,bhjv->bhdv', ki * jnp.exp(bl - bi), vi)
        return S_new, o

    S, o = lax.scan(step, s0.astype(jnp.float32), (qc, kc, vc, bc))
    o = o.transpose(1, 0, 3, 2, 4).reshape(B, L, H, DV)
    return o.astype(v.dtype), S


def token_mixer(h, w_in, q_norm, k_norm, gate_w2, gate_b, gla_norm, w_attn_o, w_gla_o, w_out, ctx):
    B, L, _ = h.shape
    q, k, v, gq, gk, gv, gout, glr, gmerge = jnp.split(h @ w_in, IN_SPLITS, axis=-1)
    q = rms_norm(q.reshape(B, L, N_HEADS, HEAD_DIM), q_norm)
    k = rms_norm(k.reshape(B, L, KV_HEADS, HEAD_DIM), k_norm)
    v = v.reshape(B, L, KV_HEADS, HEAD_DIM)
    gq = gq.reshape(B, L, GLA_HEADS, GLA_DK) * (GLA_DK ** -0.5)
    gk = gk.reshape(B, L, GLA_HEADS, GLA_DK)
    gv = gv.reshape(B, L, GLA_HEADS, GLA_DV)
    z = jnp.einsum('bldr,drk->dblk', glr.reshape(B, L, 2, GATE_RANK), gate_w2) + gate_b[:, None, None, :]
    log_a = (jax.nn.log_sigmoid(z.astype(jnp.float32)) / GATE_NORM).reshape(2, B, L, GLA_HEADS, GLA_DK)
    if ctx is None:
        attn = gqa_attend(q, k, v)
        s0_f = jnp.zeros((B, GLA_HEADS, GLA_DK, GLA_DV), jnp.float32)
        s0_b = s0_f
    else:
        ctx_k, ctx_v, s0_f, s0_b = ctx
        cos, sin = axial_rope(L, h.dtype)
        q_r = apply_rope(q, cos, sin)
        k_r = apply_rope(k, cos, sin)
        attn = gqa_attend(q_r, jnp.concatenate([k_r, ctx_k], axis=1), jnp.concatenate([v, ctx_v], axis=1))
    o_f, s_f = gla_scan(gq, gk, gv, log_a[0], s0_f)
    o_b, s_b = gla_scan(jnp.flip(gq, 1), jnp.flip(gk, 1), jnp.flip(gv, 1), jnp.flip(log_a[1], 1), s0_b)
    o = o_f + jnp.flip(o_b, 1)
    o = (rms_norm(o, gla_norm) * jax.nn.silu(gout.reshape(B, L, GLA_HEADS, GLA_DV))).reshape(B, L, GLA_V_WIDTH)
    g_attn, g_gla = jnp.split(jax.nn.sigmoid(gmerge), 2, axis=-1)
    y = (g_attn * (attn @ w_attn_o) + g_gla * (o @ w_gla_o)) @ w_out
    if ctx is None:
        return y, (k, v, s_f, s_b)
    return y, None


def peer(h, wq, sub_keys, u, v):
    B, L, D = h.shape
    nb = (B * L) // PEER_BLOCK
    xb = h.reshape(nb, PEER_BLOCK, D)

    def one_block(xt):
        q = (xt @ wq).reshape(PEER_BLOCK, PEER_HEADS, 2, PEER_HALF)
        s = jnp.einsum('thpd,pnd->thpn', q, sub_keys).astype(jnp.float32)
        s1, i1 = lax.top_k(s[:, :, 0], PEER_TOPK)
        s2, i2 = lax.top_k(s[:, :, 1], PEER_TOPK)
        cand = (s1[..., :, None] + s2[..., None, :]).reshape(PEER_BLOCK, PEER_HEADS, PEER_TOPK * PEER_TOPK)
        sc, ci = lax.top_k(cand, PEER_TOPK)
        idx = jnp.take_along_axis(i1, ci // PEER_TOPK, axis=-1) * N_KEYS + jnp.take_along_axis(i2, ci % PEER_TOPK, axis=-1)
        g = jax.nn.softmax(sc, axis=-1)
        a = jax.nn.gelu(jnp.einsum('td,thkd->thk', xt, u[idx]).astype(jnp.float32))
        return jnp.einsum('thk,thkd->td', (g * a).astype(xt.dtype), v[idx])

    return lax.map(one_block, xb).reshape(B, L, D)


def trunk_layer(x, cond, lp, ctx):
    (ada_w, ada_b, w_in, q_norm, k_norm, gate_w2, gate_b, gla_norm, w_attn_o, w_gla_o, w_out,
     ln1_g, ln1_b, ln2_g, ln2_b, peer_wq, peer_sub_keys, peer_u, peer_v) = lp
    mod = (jax.nn.silu(cond) @ ada_w + ada_b).reshape(-1, 1, 6 * D_MODEL)
    shift1, scale1, gate1, shift2, scale2, gate2 = jnp.split(mod, 6, axis=-1)
    h = x * (1.0 + scale1) + shift1
    mix, ctx_out = token_mixer(h, w_in, q_norm, k_norm, gate_w2, gate_b, gla_norm, w_attn_o, w_gla_o, w_out, ctx)
    x = layer_norm(ALPHA * x + gate1 * mix, ln1_g, ln1_b)
    h = x * (1.0 + scale2) + shift2
    x = layer_norm(ALPHA * x + gate2 * peer(h, peer_wq, peer_sub_keys, peer_u, peer_v), ln2_g, ln2_b)
    return x, ctx_out


def setup_inputs(seed: int = 0) -> dict:
    key = jax.random.key(seed)
    ks = jax.random.split(key, 32)
    f32 = jnp.float32
    nrm = lambda k, shape, scale: jax.random.normal(k, shape, f32) * scale
    return {
        'x_prompt': nrm(ks[0], (BATCH, SEQ, D_MODEL), 1.0),
        'x_sample': nrm(ks[1], (DEC_BATCH, DEC_SEQ, D_MODEL), 1.0),
        'cache_k': nrm(ks[2], (DEC_BATCH, DEPTH, PAST_LEN, KV_HEADS, HEAD_DIM), 1.0),
        'cache_v': nrm(ks[3], (DEC_BATCH, DEPTH, PAST_LEN, KV_HEADS, HEAD_DIM), 1.0),
        'state_gla': nrm(ks[4], (DEC_BATCH, DEPTH, 2, GLA_HEADS, GLA_DK, GLA_DV), 0.5),
        'c': nrm(ks[5], (DEC_BATCH, D_MODEL), 1.0),
        'c_ctx': nrm(ks[6], (D_MODEL,), 1.0),
        'ada_w': nrm(ks[7], (DEPTH, D_MODEL, 6 * D_MODEL), D_MODEL ** -0.5),
        'ada_b': nrm(ks[8], (DEPTH, 6 * D_MODEL), 0.02),
        'w_in': nrm(ks[9], (DEPTH, D_MODEL, IN_WIDTH), D_MODEL ** -0.5),
        'q_norm': 1.0 + nrm(ks[10], (DEPTH, HEAD_DIM), 0.02),
        'k_norm': 1.0 + nrm(ks[11], (DEPTH, HEAD_DIM), 0.02),
        'gate_w2': nrm(ks[12], (DEPTH, 2, GATE_RANK, GLA_QK_WIDTH), GATE_RANK ** -0.5),
        'gate_b': jax.random.uniform(ks[13], (DEPTH, 2, GLA_QK_WIDTH), f32, 1.0, 4.0),
        'gla_norm': 1.0 + nrm(ks[14], (DEPTH, GLA_DV), 0.02),
        'w_attn_o': nrm(ks[15], (DEPTH, ATT_WIDTH, D_MODEL), ATT_WIDTH ** -0.5),
        'w_gla_o': nrm(ks[16], (DEPTH, GLA_V_WIDTH, D_MODEL), GLA_V_WIDTH ** -0.5),
        'w_out': nrm(ks[17], (DEPTH, D_MODEL, D_MODEL), BETA * D_MODEL ** -0.5),
        'ln1_g': 1.0 + nrm(ks[18], (DEPTH, D_MODEL), 0.02),
        'ln1_b': nrm(ks[19], (DEPTH, D_MODEL), 0.02),
        'ln2_g': 1.0 + nrm(ks[20], (DEPTH, D_MODEL), 0.02),
        'ln2_b': nrm(ks[21], (DEPTH, D_MODEL), 0.02),
        'peer_wq': nrm(ks[22], (DEPTH, D_MODEL, PEER_HEADS * PEER_QDIM), D_MODEL ** -0.5),
        'peer_sub_keys': nrm(ks[23], (DEPTH, 2, N_KEYS, PEER_HALF), PEER_HALF ** -0.5),
        'peer_u': nrm(ks[24], (DEPTH, N_EXPERTS, D_MODEL), D_MODEL ** -0.5),
        'peer_v': nrm(ks[25], (DEPTH, N_EXPERTS, D_MODEL), BETA * PEER_HEADS ** -0.5),
    }


def reference(x_prompt, x_sample, cache_k, cache_v, state_gla, c, c_ctx, ada_w, ada_b, w_in, q_norm, k_norm,
              gate_w2, gate_b, gla_norm, w_attn_o, w_gla_o, w_out, ln1_g, ln1_b, ln2_g, ln2_b,
              peer_wq, peer_sub_keys, peer_u, peer_v):
    params = (ada_w, ada_b, w_in, q_norm, k_norm, gate_w2, gate_b, gla_norm, w_attn_o, w_gla_o, w_out,
              ln1_g, ln1_b, ln2_g, ln2_b, peer_wq, peer_sub_keys, peer_u, peer_v)
    xp = x_prompt
    ks, vs, ss = [], [], []
    for l in range(DEPTH):
        lp = tuple(p[l] for p in params)
        xp, (k_l, v_l, sf_l, sb_l) = trunk_layer(xp, c_ctx, lp, None)
        ks.append(k_l)
        vs.append(v_l)
        ss.append(jnp.stack([sf_l, sb_l], axis=1))
    new_cache_k = jnp.stack(ks, axis=1)
    new_cache_v = jnp.stack(vs, axis=1)
    new_state_gla = jnp.stack(ss, axis=1)
    xs = x_sample
    for l in range(DEPTH):
        lp = tuple(p[l] for p in params)
        ctx = (cache_k[:, l], cache_v[:, l], state_gla[:, l, 0], state_gla[:, l, 1])
        xs, _ = trunk_layer(xs, c, lp, ctx)
    return (xp, xs, new_cache_k, new_cache_v, new_state_gla)
```

```cpp
#include <hip/hip_runtime.h>
#include <hip/hip_cooperative_groups.h>
#include <cstdio>
#include <cstdint>
namespace cg = cooperative_groups;

typedef unsigned short u16;
typedef __attribute__((ext_vector_type(8))) short bf16x8;
typedef __attribute__((ext_vector_type(4))) float f32x4;
typedef __attribute__((ext_vector_type(4))) unsigned u32x4;
typedef __attribute__((ext_vector_type(2))) float f32x2_t;
typedef __attribute__((ext_vector_type(2))) __bf16 bf16x2_t;

constexpr int DM = 1024;
constexpr int NTOK = 12288, NCTX = 8192;
constexpr int INW = 6688, INWP = 6784;
constexpr int LKEYS = 1536;
constexpr float ALPHA = 1.4142135623730951f;
constexpr int NPHASE = 20;

constexpr size_t MB = 1024ull * 1024ull;
constexpr size_t OFF_BAR  = 0;
constexpr size_t OFF_WINT = 16384;
constexpr size_t OFF_WAOT = OFF_WINT + 2ull * INWP * 1024 * 2;
constexpr size_t OFF_WGOT = OFF_WAOT + 4 * MB;
constexpr size_t OFF_WOUT = OFF_WGOT + 4 * MB;
constexpr size_t OFF_WQT  = OFF_WOUT + 4 * MB;
constexpr size_t OFF_SKB  = OFF_WQT + 8 * MB;
constexpr size_t OFF_U16  = OFF_SKB + 131072;
constexpr size_t OFF_V16  = OFF_U16 + 32 * MB;
constexpr size_t OFF_MOD  = OFF_V16 + 32 * MB;
constexpr size_t OFF_ROPE = OFF_MOD + 262144;
constexpr size_t OFF_X    = OFF_ROPE + 262144;
constexpr size_t OFF_H    = OFF_X + 48 * MB;
constexpr size_t OFF_Q    = OFF_H + 24 * MB;
constexpr size_t OFF_KC   = OFF_Q + 24 * MB;
constexpr size_t OFF_KL   = OFF_KC + 4 * MB;
constexpr size_t OFF_VTC  = OFF_KL + 6 * MB;
constexpr size_t OFF_VTL  = OFF_VTC + 4 * MB;
constexpr size_t OFF_GQ   = OFF_VTL + 6 * MB;
constexpr size_t OFF_GK   = OFF_GQ + 12 * MB;
constexpr size_t OFF_GV   = OFF_GK + 12 * MB;
constexpr size_t OFF_GOUT = OFF_GV + 24 * MB;
constexpr size_t OFF_GLR  = OFF_GOUT + 24 * MB;
constexpr size_t OFF_GM   = OFF_GLR + 2 * MB;
constexpr size_t OFF_ATT  = OFF_GM + 48 * MB;
constexpr size_t OFF_OF   = OFF_ATT + 24 * MB;
constexpr size_t OFF_OB   = OFF_OF + 24 * MB;
constexpr size_t OFF_KT   = OFF_OB + 24 * MB;
constexpr size_t OFF_PM   = OFF_KT + 24 * MB;
constexpr size_t OFF_EBL  = OFF_PM + 12 * MB;
constexpr size_t WS_NEED  = OFF_EBL + 1 * MB;
constexpr size_t OFF_QE   = OFF_H;
constexpr size_t OFF_PRE  = OFF_GV;
constexpr size_t OFF_S1   = OFF_GM;
constexpr size_t OFF_EI   = OFF_S1 + 13 * MB;
constexpr size_t OFF_EG   = OFF_EI + 6 * MB;

struct Params {
  const float *x_prompt, *x_sample, *cache_k, *cache_v, *state_gla, *c, *c_ctx, *ada_w, *ada_b, *w_in, *q_norm, *k_norm,
      *gate_w2, *gate_b, *gla_norm, *w_attn_o, *w_gla_o, *w_out, *ln1_g, *ln1_b, *ln2_g, *ln2_b, *peer_wq, *peer_sub_keys,
      *peer_u, *peer_v;
  float* out;
  char* ws;
};

constexpr size_t OUT_Y   = 0;
constexpr size_t OUT_K   = (size_t)NTOK * DM;
constexpr size_t OUT_V   = OUT_K + 32ull * 2 * 256 * 256;
constexpr size_t OUT_S   = OUT_V + 32ull * 2 * 256 * 256;

__device__ __forceinline__ unsigned pack2(float lo, float hi) {
  f32x2_t v = {lo, hi};
  bf16x2_t b = __builtin_convertvector(v, bf16x2_t);
  return __builtin_bit_cast(unsigned, b);
}
__device__ __forceinline__ u16 f2bf(float f) { return (u16)(pack2(f, 0.f) & 0xffffu); }
__device__ __forceinline__ float bf2f(u16 h) { return __uint_as_float(((unsigned)h) << 16); }
__device__ __forceinline__ float bf_lo(unsigned u) { return __uint_as_float(u << 16); }
__device__ __forceinline__ float bf_hi(unsigned u) { return __uint_as_float(u & 0xffff0000u); }
__device__ __forceinline__ float sigmoidf_(float x) { return 1.f / (1.f + __expf(-x)); }
__device__ __forceinline__ float siluf_(float x) { return x / (1.f + __expf(-x)); }
__device__ __forceinline__ float geluf_(float x) {
  float u = 0.7978845608028654f * (x + 0.044715f * x * x * x);
  float t = 1.f - 2.f / (1.f + __expf(2.f * u));
  return 0.5f * x * (1.f + t);
}
__device__ __forceinline__ int tok_group(int token) { return token < NCTX ? 0 : 1 + ((token - NCTX) >> 10); }
__device__ __forceinline__ float wave_sum(float v) {
#pragma unroll
  for (int m = 32; m >= 1; m >>= 1) v += __shfl_xor(v, m);
  return v;
}
__device__ __forceinline__ bf16x8 mk8(uint2 a, uint2 b) {
  uint4 u = make_uint4(a.x, a.y, b.x, b.y);
  return __builtin_bit_cast(bf16x8, u);
}
__device__ __forceinline__ bf16x8 ld8(const u16* p) { return *(const bf16x8*)p; }
#define MFMA16(a, b, c) __builtin_amdgcn_mfma_f32_16x16x32_bf16((a), (b), (c), 0, 0, 0)

#define XB_TMO      128
#define XB_XCNT(j)  (256  + 64 * (j))
#define XB_XSUB(j)  (1280 + 64 * (j))
#define XB_XGEN(j)  (2304 + 64 * (j))
#define XB_TOP      3328
#define XB_TOPGEN   3392
#define XCD_BAR_WORDS 3456
#define XB_SPIN_CAP (1u << 22)
#define LAS __attribute__((address_space(3)))
__device__ __forceinline__ unsigned xb_ld(unsigned* p) { return __hip_atomic_load(p, __ATOMIC_RELAXED, __HIP_MEMORY_SCOPE_AGENT); }
__device__ __forceinline__ unsigned xb_add(unsigned* p, unsigned v) { return __hip_atomic_fetch_add(p, v, __ATOMIC_RELAXED, __HIP_MEMORY_SCOPE_AGENT); }
__device__ __forceinline__ unsigned xb_xcc_id() { return (unsigned)__builtin_amdgcn_s_getreg((3 << 11) | 20) & 0xFu; }
#define XB_SPIN(cond, bar) do { unsigned _sp = 0; while (cond) { __builtin_amdgcn_s_sleep(4); \
    if ((++_sp & 255u) == 0u) { if (xb_ld(&(bar)[XB_TMO])) break; if (_sp > XB_SPIN_CAP) { atomicAdd(&(bar)[XB_TMO], 1u); break; } } } } while (0)
struct XcdBarrier { unsigned* bar; unsigned x; volatile LAS unsigned* st; };
__device__ __forceinline__ XcdBarrier xcd_barrier_post(unsigned* bar, volatile LAS unsigned* st) {
  XcdBarrier b; b.bar = bar; b.x = xb_xcc_id(); b.st = st;
  if (threadIdx.x == 0) (void)xb_add(&bar[XB_XCNT(b.x)], 1u);
  return b;
}
__device__ __forceinline__ void xcd_barrier_complete(unsigned* bar, unsigned x, unsigned& nloc, unsigned& nx) {
  const unsigned G = gridDim.x * gridDim.y * gridDim.z;
  unsigned sum, cnt, mine, sp = 0u;
  for (;;) {
    sum = 0u; cnt = 0u; mine = 0u;
#pragma unroll
    for (unsigned j = 0; j < 16; ++j) { const unsigned c = xb_ld(&bar[XB_XCNT(j)]); sum += c; cnt += (c > 0u) ? 1u : 0u; mine = (j == x) ? c : mine; }
    if (sum == G) break;
    __builtin_amdgcn_s_sleep(1);
    if ((++sp & 255u) == 0u) { if (xb_ld(&bar[XB_TMO])) break; if (sp > XB_SPIN_CAP) { atomicAdd(&bar[XB_TMO], 1u); break; } }
  }
  nloc = mine > 0u ? mine : 1u; nx = cnt > 0u ? cnt : 1u;
}
__device__ __forceinline__ void xcd_barrier(const XcdBarrier& b) {
  asm volatile("s_waitcnt vmcnt(0)" ::: "memory");
  __syncthreads();
  if (threadIdx.x == 0) {
    unsigned* bar = b.bar;
    __builtin_amdgcn_s_waitcnt(0);
    unsigned nloc = b.st[0], nx = b.st[1];
    if (nloc == 0u) { xcd_barrier_complete(bar, b.x, nloc, nx); b.st[0] = nloc; b.st[1] = nx; }
    const unsigned old = xb_add(&bar[XB_XSUB(b.x)], 1u);
    const unsigned gen = old / nloc;
    if (old + 1u == (gen + 1u) * nloc) {
      __builtin_amdgcn_fence(__ATOMIC_RELEASE, "agent");
      asm volatile("s_waitcnt vmcnt(0)" ::: "memory");
      const unsigned og = xb_add(&bar[XB_TOP], 1u);
      const unsigned tg = og / nx;
      if (og + 1u == (tg + 1u) * nx) xb_add(&bar[XB_TOPGEN], 1u);
      else XB_SPIN(xb_ld(&bar[XB_TOPGEN]) == tg, bar);
      __builtin_amdgcn_fence(__ATOMIC_ACQUIRE, "agent");
      xb_add(&bar[XB_XGEN(b.x)], 1u);
      asm volatile("s_waitcnt vmcnt(0)" ::: "memory");
    } else {
      XB_SPIN(xb_ld(&bar[XB_XGEN(b.x)]) == gen, bar);
      __builtin_amdgcn_fence(__ATOMIC_ACQUIRE, "agent");
      asm volatile("s_waitcnt vmcnt(0)" ::: "memory");
    }
  }
  __syncthreads();
}

#define LDT 72
#define LDC 132
__device__ __forceinline__ void gemm_compute64(f32x4 (&acc)[4][4], const u16* sA, const u16* sB, int wr, int wc, int r16, int quad) {
#pragma unroll
  for (int kk = 0; kk < 2; kk++) {
    const int co = ((kk * 4 + quad) ^ (r16 & 7)) * 8;
    bf16x8 a[4], b[4];
#pragma unroll
    for (int i = 0; i < 4; i++) a[i] = ld8(sA + (wr * 64 + i * 16 + r16) * 64 + co);
#pragma unroll
    for (int j = 0; j < 4; j++) b[j] = ld8(sB + (wc * 64 + j * 16 + r16) * 64 + co);
#pragma unroll
    for (int i = 0; i < 4; i++)
#pragma unroll
      for (int j = 0; j < 4; j++) acc[i][j] = MFMA16(a[i], b[j], acc[i][j]);
  }
}
#define GT_LOAD(RA, RB, KOFF) { _Pragma("unroll") for (int i = 0; i < 4; i++) { RA[i] = *(const u32x4*)((A + ((KOFF) + i * 32 * lda)) + va); RB[i] = *(const u32x4*)((B + ((KOFF) + i * 32 * ldb)) + vb); } }
#define GT_STORE(RA, RB, BUF) { u16* _a = smem16 + (BUF) * 16384; _Pragma("unroll") for (int i = 0; i < 4; i++) { *(u32x4*)(_a + (lrow + 32 * i) * 64 + lsw) = RA[i]; *(u32x4*)(_a + 8192 + (lrow + 32 * i) * 64 + lsw) = RB[i]; } }
#define GT_COMPUTE(BUF) gemm_compute64(acc, smem16 + (BUF) * 16384, smem16 + (BUF) * 16384 + 8192, wr, wc, r16, quad)
__device__ __forceinline__ void gemm_tile(f32x4 (&acc)[4][4], const u16* __restrict__ A, int lda, const u16* __restrict__ B, int ldb,
                                          int K, u16* smem16, u16* unused_) {
  const int tid = threadIdx.x, lane = tid & 63, wid = tid >> 6, wr = wid >> 1, wc = wid & 1, r16 = lane & 15, quad = lane >> 4;
  const int lrow = tid >> 3, lkc = (tid & 7) * 8, lsw = ((tid & 7) ^ (lrow & 7)) * 8;
  const unsigned va = lrow * lda + lkc, vb = lrow * ldb + lkc;
  u32x4 ra0[4], rb0[4], ra1[4], rb1[4];
  const int nk = K >> 6;
  GT_LOAD(ra0, rb0, 0);
  GT_LOAD(ra1, rb1, 64);
  __syncthreads();
  GT_STORE(ra0, rb0, 0);
  GT_LOAD(ra0, rb0, 128);
  __syncthreads();
  for (int kt = 0; kt < nk; kt += 2) {
    GT_STORE(ra1, rb1, 1);
    { const int kn = min(kt + 3, nk - 1) * 64; GT_LOAD(ra1, rb1, kn); }
    GT_COMPUTE(0);
    __syncthreads();
    GT_STORE(ra0, rb0, 0);
    { const int kn = min(kt + 4, nk - 1) * 64; GT_LOAD(ra0, rb0, kn); }
    GT_COMPUTE(1);
    __syncthreads();
  }
}
__device__ __forceinline__ void gemm_tile2(f32x4 (&acc)[4][4], const u16* __restrict__ A, int lda, const u16* __restrict__ B, int ldb,
                                           int K, u16* smem16) {
  const int tid = threadIdx.x, lane = tid & 63, wid = tid >> 6, wr = wid >> 1, wc = wid & 1, r16 = lane & 15, quad = lane >> 4;
  const int lrow = tid >> 3, lkc = (tid & 7) * 8, lsw = ((tid & 7) ^ (lrow & 7)) * 8;
  const unsigned va = lrow * lda + lkc, vb = lrow * ldb + lkc;
  u32x4 ra0[4], rb0[4];
  const int nk = K >> 6;
  GT_LOAD(ra0, rb0, 0);
  __syncthreads();
  GT_STORE(ra0, rb0, 0);
  GT_LOAD(ra0, rb0, 64);
  __syncthreads();
  const int co0 = ((0 + quad) ^ (r16 & 7)) * 8, co1 = ((4 + quad) ^ (r16 & 7)) * 8;
#pragma unroll 1
  for (int kt = 0; kt < nk; kt++) {
    const u16* sAc = smem16 + (kt & 1) * 16384; const u16* sBc = sAc + 8192;
    bf16x8 a0[4], b0[4], a1[4], b1[4];
#pragma unroll
    for (int i = 0; i < 4; i++) { a0[i] = ld8(sAc + (wr * 64 + i * 16 + r16) * 64 + co0); a1[i] = ld8(sAc + (wr * 64 + i * 16 + r16) * 64 + co1); }
#pragma unroll
    for (int j = 0; j < 4; j++) { b0[j] = ld8(sBc + (wc * 64 + j * 16 + r16) * 64 + co0); b1[j] = ld8(sBc + (wc * 64 + j * 16 + r16) * 64 + co1); }
    __builtin_amdgcn_sched_barrier(0);
    {
      u16* _a = smem16 + ((kt + 1) & 1) * 16384;
#pragma unroll
      for (int i = 0; i < 4; i++) { *(u32x4*)(_a + (lrow + 32 * i) * 64 + lsw) = ra0[i]; *(u32x4*)(_a + 8192 + (lrow + 32 * i) * 64 + lsw) = rb0[i]; }
    }
    { const int kn = min(kt + 2, nk - 1) * 64; GT_LOAD(ra0, rb0, kn); }
    __builtin_amdgcn_sched_barrier(0);
#pragma unroll
    for (int i = 0; i < 4; i++)
#pragma unroll
      for (int j = 0; j < 4; j++) acc[i][j] = MFMA16(a0[i], b0[j], acc[i][j]);
#pragma unroll
    for (int i = 0; i < 4; i++)
#pragma unroll
      for (int j = 0; j < 4; j++) acc[i][j] = MFMA16(a1[i], b1[j], acc[i][j]);
    __syncthreads();
  }
}
__device__ __forceinline__ void gemm_tile1(f32x4 (&acc)[4][4], const u16* __restrict__ A, int lda, const u16* __restrict__ B, int ldb,
                                           int K, u16* smem16, u16* unused_) {
  const int tid = threadIdx.x, lane = tid & 63, wid = tid >> 6, wr = wid >> 1, wc = wid & 1, r16 = lane & 15, quad = lane >> 4;
  const int lrow = tid >> 3, lkc = (tid & 7) * 8, lsw = ((tid & 7) ^ (lrow & 7)) * 8;
  const unsigned va = lrow * lda + lkc, vb = lrow * ldb + lkc;
  u32x4 ra0[4], rb0[4];
  const int nk = K >> 6;
  GT_LOAD(ra0, rb0, 0);
  __syncthreads();
  GT_STORE(ra0, rb0, 0);
  GT_LOAD(ra0, rb0, 64);
  __syncthreads();
  for (int kt = 0; kt < nk; kt += 2) {
    GT_STORE(ra0, rb0, 1);
    { const int kn = min(kt + 2, nk - 1) * 64; GT_LOAD(ra0, rb0, kn); }
    GT_COMPUTE(0);
    __syncthreads();
    GT_STORE(ra0, rb0, 0);
    { const int kn = min(kt + 3, nk - 1) * 64; GT_LOAD(ra0, rb0, kn); }
    GT_COMPUTE(1);
    __syncthreads();
  }
}
__device__ __forceinline__ void acc_zero(f32x4 (&acc)[4][4]) {
#pragma unroll
  for (int i = 0; i < 4; i++)
#pragma unroll
    for (int j = 0; j < 4; j++) acc[i][j] = (f32x4){0.f, 0.f, 0.f, 0.f};
}
__device__ __forceinline__ void acc_to_lds(const f32x4 (&acc)[4][4], float* sC) {
  const int tid = threadIdx.x, lane = tid & 63, wid = tid >> 6, wr = wid >> 1, wc = wid & 1, r16 = lane & 15, quad = lane >> 4;
  __syncthreads();
#pragma unroll
  for (int i = 0; i < 4; i++)
#pragma unroll
    for (int j = 0; j < 4; j++)
#pragma unroll
      for (int e = 0; e < 4; e++) sC[(wr * 64 + i * 16 + quad * 4 + e) * LDC + wc * 64 + j * 16 + r16] = acc[i][j][e];
  __syncthreads();
}
__device__ __forceinline__ void load_row64(float (&v)[64], const float* sC, int row, int half) {
  const float4* s = (const float4*)(sC + row * LDC + half * 64);
#pragma unroll
  for (int i = 0; i < 16; i++) { float4 t = s[i]; v[4 * i] = t.x; v[4 * i + 1] = t.y; v[4 * i + 2] = t.z; v[4 * i + 3] = t.w; }
}
__device__ __forceinline__ void store64_bf16(u16* dst, const float (&v)[64]) {
#pragma unroll
  for (int i = 0; i < 8; i++) {
    uint4 w = make_uint4(pack2(v[8 * i], v[8 * i + 1]), pack2(v[8 * i + 2], v[8 * i + 3]), pack2(v[8 * i + 4], v[8 * i + 5]), pack2(v[8 * i + 6], v[8 * i + 7]));
    ((uint4*)dst)[i] = w;
  }
}
__device__ __forceinline__ void store64_f32(float* dst, const float (&v)[64]) {
#pragma unroll
  for (int i = 0; i < 16; i++) ((float4*)dst)[i] = make_float4(v[4 * i], v[4 * i + 1], v[4 * i + 2], v[4 * i + 3]);
}

__device__ __forceinline__ bool xcd_tile(int q, int ncol, int& mt, int& nt) {
  const int x = blockIdx.x & 7;
  if (q >= 12 * ncol) return false;
  nt = q / 12; mt = (q % 12) * 8 + x;
  return true;
}
__device__ __forceinline__ void transpose_item(const Params& p, int item, char* smem) {
  char* ws = p.ws; const int tid = threadIdx.x; u16* tt = (u16*)smem;
      const int l = item / 1476, r = item % 1476, grp = r >> 2, kq = r & 3;
      const float* S; int sN, n0, drow0; u16* Dst;
      if (grp < 209) { S = p.w_in + (size_t)l * 1024 * INW; sN = INW; n0 = grp * 32; drow0 = grp < 145 ? n0 : n0 + 96; Dst = (u16*)(ws + OFF_WINT) + (size_t)l * INWP * 1024; }
      else if (grp < 241) { S = p.w_attn_o + (size_t)l * 1048576; sN = 1024; n0 = (grp - 209) * 32; drow0 = n0; Dst = (u16*)(ws + OFF_WAOT) + (size_t)l * 1048576; }
      else if (grp < 273) { S = p.w_gla_o + (size_t)l * 1048576; sN = 1024; n0 = (grp - 241) * 32; drow0 = n0; Dst = (u16*)(ws + OFF_WGOT) + (size_t)l * 1048576; }
      else if (grp < 305) { S = p.w_out + (size_t)l * 1048576; sN = 1024; n0 = (grp - 273) * 32; drow0 = n0; Dst = (u16*)(ws + OFF_WOUT) + (size_t)l * 1048576; }
      else { S = p.peer_wq + (size_t)l * 2097152; sN = 2048; n0 = (grp - 305) * 32; drow0 = n0; Dst = (u16*)(ws + OFF_WQT) + (size_t)l * 2097152; }
      const int k0 = kq * 256;
      const int rr = tid >> 3, c4 = tid & 7;
      __syncthreads();
#pragma unroll
      for (int it = 0; it < 8; it++) {
        const int k = it * 32 + rr;
        const f32x4 v = __builtin_nontemporal_load((const f32x4*)(S + (size_t)(k0 + k) * sN + n0 + c4 * 4));
        tt[(c4 * 4 + 0) * 264 + k] = f2bf(v.x); tt[(c4 * 4 + 1) * 264 + k] = f2bf(v.y);
        tt[(c4 * 4 + 2) * 264 + k] = f2bf(v.z); tt[(c4 * 4 + 3) * 264 + k] = f2bf(v.w);
      }
      __syncthreads();
#pragma unroll
      for (int it = 0; it < 4; it++) {
        const int ch = c4 + 8 * it;
        *(uint4*)(Dst + (size_t)(drow0 + rr) * 1024 + k0 + ch * 8) = *(const uint4*)(tt + rr * 264 + ch * 8);
      }
}
__device__ __forceinline__ void transpose_layer1_idle(const Params& p, char* smem) {
  const int j = blockIdx.x >> 3, x = blockIdx.x & 7, nj = gridDim.x >> 3, jh = nj >> 1, nconv = nj - jh;
  if (j < jh) return;
  const int part = x * nconv + (j - jh), nparts = 8 * nconv;
  __syncthreads();
  for (int item = 1476 + part; item < 2952; item += nparts) transpose_item(p, item, smem);
  __syncthreads();
}
__device__ __forceinline__ void conv_peer_table(const Params& p, int which, int lay) {
  const int j = blockIdx.x >> 3, x = blockIdx.x & 7, nj = gridDim.x >> 3, jh = nj >> 1, nconv = nj - jh;
  if (j < jh) return;
  const int part = x * nconv + (j - jh), nparts = 8 * nconv;
  const float* src = (which == 0 ? p.peer_u : p.peer_v) + (size_t)lay * 16384 * 1024;
  char* dstb = p.ws + (which == 0 ? OFF_U16 : OFF_V16) + (size_t)lay * 16384 * 1024;
  const float sc = which == 0 ? 128.f : 16.f;
  const size_t nch = 16384ull * 1024 / 8, per = (nch + nparts - 1) / nparts;
  const size_t c0 = (size_t)part * per, c1 = c0 + per < nch ? c0 + per : nch;
  for (size_t i = c0 + threadIdx.x; i < c1; i += 256) {
    const f32x4 a = __builtin_nontemporal_load((const f32x4*)src + 2 * i), b = __builtin_nontemporal_load((const f32x4*)src + 2 * i + 1);
    int lo = 0, hi = 0;
    lo = __builtin_amdgcn_cvt_pk_fp8_f32(a.x * sc, a.y * sc, lo, false); lo = __builtin_amdgcn_cvt_pk_fp8_f32(a.z * sc, a.w * sc, lo, true);
    hi = __builtin_amdgcn_cvt_pk_fp8_f32(b.x * sc, b.y * sc, hi, false); hi = __builtin_amdgcn_cvt_pk_fp8_f32(b.z * sc, b.w * sc, hi, true);
    ((int2*)dstb)[i] = make_int2(lo, hi);
  }
}
__device__ __forceinline__ void phase_prep(const Params& p, char* smem) {
  const int tid = threadIdx.x;
  const int G = gridDim.x;
  const size_t gtid = (size_t)blockIdx.x * 256 + tid, gsz = (size_t)G * 256;
  char* ws = p.ws;
  for (int item = blockIdx.x; item < 1476; item += G) transpose_item(p, item, smem);
  __syncthreads();
  for (size_t i = gtid; i < 2ull * 96 * 128; i += gsz) {
    const int l = (int)(i / (96 * 128)); const size_t r = i % (96 * 128);
    ((uint4*)((u16*)(ws + OFF_WINT) + ((size_t)l * INWP + 4640) * 1024))[r] = make_uint4(0, 0, 0, 0);
  }
  {
    for (size_t i = gtid; i < 65536 / 8; i += gsz) {
      const float4 a = ((const float4*)p.peer_sub_keys)[2 * i], b = ((const float4*)p.peer_sub_keys)[2 * i + 1];
      ((uint4*)(ws + OFF_SKB))[i] = make_uint4(pack2(a.x, a.y), pack2(a.z, a.w), pack2(b.x, b.y), pack2(b.z, b.w));
    }
  }
  for (size_t i = gtid; i < 32768; i += gsz) {
    const int pos = (int)(i >> 5), j = (int)(i & 31), a = j >> 4, f = j & 15;
    const float coord = (float)(a == 0 ? (pos >> 6) : (pos & 63));
    const float inv = exp2f(-(float)f * (13.287712379549449f / 16.f));
    const float ang = coord * inv;
    ((float*)(ws + OFF_ROPE))[i] = cosf(ang);
    ((float*)(ws + OFF_ROPE))[32768 + i] = sinf(ang);
  }
  for (size_t i = gtid; i < 4ull * 2 * 512 * 256; i += gsz) {
    const int d = (int)(i & 63), kvh = (int)((i >> 6) & 3), j = (int)((i >> 8) & 511), l = (int)((i >> 17) & 1), b = (int)(i >> 18);
    ((u16*)(ws + OFF_KL))[(((size_t)l * 4 + b) * LKEYS + 1024 + j) * 256 + kvh * 64 + d] = f2bf(p.cache_k[i]);
    ((u16*)(ws + OFF_VTL))[((((size_t)l * 4 + b) * 4 + kvh) * 64 + d) * LKEYS + 1024 + j] = f2bf(p.cache_v[i]);
  }
  {
    float* sc = (float*)smem;
    float* red = (float*)(smem + 20480);
    for (int item = blockIdx.x; item < 384; item += G) {
      const int l = item / 192, n0 = (item % 192) * 32;
      __syncthreads();
      for (int i = tid; i < 5120; i += 256) {
        const int g = i >> 10, k = i & 1023;
        const float cv = g == 0 ? p.c_ctx[k] : p.c[(g - 1) * 1024 + k];
        sc[i] = siluf_(cv);
      }
      __syncthreads();
      const int c = tid & 31, kg = tid >> 5;
      float a0 = 0, a1 = 0, a2 = 0, a3 = 0, a4 = 0;
      const float* w = p.ada_w + ((size_t)l * 1024 + kg * 128) * 6144 + n0 + c;
      const float* s0 = sc + kg * 128;
#pragma unroll 8
      for (int k = 0; k < 128; k++) {
        const float wv = __builtin_nontemporal_load(w + (size_t)k * 6144);
        a0 += s0[k] * wv; a1 += s0[1024 + k] * wv; a2 += s0[2048 + k] * wv; a3 += s0[3072 + k] * wv; a4 += s0[4096 + k] * wv;
      }
      red[(kg * 5 + 0) * 32 + c] = a0; red[(kg * 5 + 1) * 32 + c] = a1; red[(kg * 5 + 2) * 32 + c] = a2;
      red[(kg * 5 + 3) * 32 + c] = a3; red[(kg * 5 + 4) * 32 + c] = a4;
      __syncthreads();
      if (tid < 160) {
        const int g = tid >> 5, cc = tid & 31;
        float s = 0;
#pragma unroll
        for (int q = 0; q < 8; q++) s += red[(q * 5 + g) * 32 + cc];
        ((float*)(ws + OFF_MOD))[((size_t)l * 5 + g) * 6144 + n0 + cc] = s + p.ada_b[(size_t)l * 6144 + n0 + cc];
      }
    }
    __syncthreads();
  }
}

__device__ __forceinline__ void phase_xin(const Params& p) {
  const size_t gtid = (size_t)blockIdx.x * 256 + threadIdx.x, gsz = (size_t)gridDim.x * 256;
  const float* mod = (const float*)(p.ws + OFF_MOD);
  for (size_t i = gtid; i < (size_t)NTOK * 256; i += gsz) {
    const int token = (int)(i >> 8), c = (int)(i & 255) * 4;
    const f32x4 xv = token < NCTX ? __builtin_nontemporal_load((const f32x4*)p.x_prompt + i) : __builtin_nontemporal_load((const f32x4*)p.x_sample + (i - (size_t)NCTX * 256));
    const float4 x = make_float4(xv.x, xv.y, xv.z, xv.w);
    const float* m = mod + (size_t)tok_group(token) * 6144;
    const float4 sh = *(const float4*)(m + c), sc = *(const float4*)(m + 1024 + c);
    uint2 w = make_uint2(pack2(x.x * (1.f + sc.x) + sh.x, x.y * (1.f + sc.y) + sh.y), pack2(x.z * (1.f + sc.z) + sh.z, x.w * (1.f + sc.w) + sh.w));
    ((uint2*)(p.ws + OFF_H))[i] = w;
  }
}

__device__ __forceinline__ void phase_gemm1(const Params& p, int l, char* smem) {
  char* ws = p.ws;
  u16* sA = (u16*)smem; u16* sB = sA + 128 * LDT; float* sC = (float*)smem;
  const int tid = threadIdx.x;
  const u16* H = (const u16*)(ws + OFF_H);
  const u16* W = (const u16*)(ws + OFF_WINT) + (size_t)l * INWP * 1024;
  const float* ropeC = (const float*)(ws + OFF_ROPE); const float* ropeS = ropeC + 32768;
  for (int q = blockIdx.x >> 3; ; q += gridDim.x >> 3) {
    int mt, nt; if (!xcd_tile(q, 53, mt, nt)) break;
    const int t0 = mt * 128;
    f32x4 acc[4][4]; acc_zero(acc);
    gemm_tile2(acc, H + (size_t)t0 * 1024, 1024, W + (size_t)nt * 128 * 1024, 1024, 1024, sA);
    acc_to_lds(acc, sC);
    const int row = tid >> 1, half = tid & 1, token = t0 + row;
    const bool lat = t0 >= NCTX;
    const int bb = lat ? (t0 - NCTX) >> 10 : t0 >> 8;
    const int pos = lat ? (token - NCTX) & 1023 : token & 255;
    const int pos0 = lat ? (t0 - NCTX) & 1023 : t0 & 255;
    if (nt < 10) {
      float v[64]; load_row64(v, sC, row, half);
      float ss = 0;
#pragma unroll
      for (int c = 0; c < 64; c++) ss += v[c] * v[c];
      const float r = rsqrtf(ss * (1.f / 64.f) + 1e-6f) * (nt < 8 ? 0.125f : 1.f);
      const float* nw = (nt < 8 ? p.q_norm : p.k_norm) + l * 64;
#pragma unroll
      for (int c = 0; c < 64; c++) v[c] = v[c] * r * nw[c];
      if (lat) {
        const float* cp = ropeC + pos * 32; const float* sp = ropeS + pos * 32;
#pragma unroll
        for (int a = 0; a < 2; a++)
#pragma unroll
          for (int f = 0; f < 16; f++) {
            const float cs = cp[a * 16 + f], sn = sp[a * 16 + f];
            const float x1 = v[a * 32 + f], x2 = v[a * 32 + 16 + f];
            v[a * 32 + f] = x1 * cs - x2 * sn; v[a * 32 + 16 + f] = x2 * cs + x1 * sn;
          }
      }
      {
        float4* d = (float4*)(sC + row * LDC + half * 64);
#pragma unroll
        for (int i = 0; i < 16; i++) d[i] = make_float4(v[4 * i], v[4 * i + 1], v[4 * i + 2], v[4 * i + 3]);
      }
      __syncthreads();
      u16* dst; size_t rstride;
      if (nt < 8) { dst = (u16*)(ws + OFF_Q) + (size_t)t0 * 1024 + nt * 128; rstride = 1024; }
      else if (!lat) { dst = (u16*)(ws + OFF_KC) + (size_t)t0 * 256 + (nt - 8) * 128; rstride = 256; }
      else { dst = (u16*)(ws + OFF_KL) + (((size_t)l * 4 + bb) * LKEYS + pos0) * 256 + (nt - 8) * 128; rstride = 256; }
#pragma unroll 2
      for (int i = 0; i < 8; i++) {
        const int id = i * 256 + tid, rr = id >> 4, c8 = (id & 15) * 8;
        const float4 a = *(const float4*)(sC + rr * LDC + c8), b2 = *(const float4*)(sC + rr * LDC + c8 + 4);
        *(uint4*)(dst + (size_t)rr * rstride + c8) = make_uint4(pack2(a.x, a.y), pack2(a.z, a.w), pack2(b2.x, b2.y), pack2(b2.z, b2.w));
      }
      if (nt >= 8 && !lat) {
        float* ok = p.out + OUT_K + (((size_t)bb * 2 + l) * 256 + pos0) * 256 + (nt - 8) * 128;
#pragma unroll 4
        for (int i = 0; i < 16; i++) {
          const int id = i * 256 + tid, rr = id >> 5, c4 = (id & 31) * 4;
          *(float4*)(ok + (size_t)rr * 256 + c4) = *(const float4*)(sC + rr * LDC + c4);
        }
      }
    } else if (nt < 12) {
      if (!lat) {
        float* ov = p.out + OUT_V + (((size_t)bb * 2 + l) * 256 + pos0) * 256 + (nt - 10) * 128;
#pragma unroll 4
        for (int i = 0; i < 16; i++) {
          const int id = i * 256 + tid, rr = id >> 5, c4 = (id & 31) * 4;
          *(float4*)(ov + (size_t)rr * 256 + c4) = *(const float4*)(sC + rr * LDC + c4);
        }
      }
#pragma unroll 2
      for (int i = 0; i < 8; i++) {
        const int id = i * 256 + tid, col = id >> 4, tc = id & 15, kvh = (nt - 10) * 2 + (col >> 6), d = col & 63;
        const float* sp = sC + (tc * 8) * LDC + col;
        u16* dst = lat ? (u16*)(ws + OFF_VTL) + ((((size_t)l * 4 + bb) * 4 + kvh) * 64 + d) * LKEYS + pos0 + tc * 8
                       : (u16*)(ws + OFF_VTC) + (((size_t)bb * 4 + kvh) * 64 + d) * 256 + pos0 + tc * 8;
        *(uint4*)dst = make_uint4(pack2(sp[0], sp[LDC]), pack2(sp[2 * LDC], sp[3 * LDC]), pack2(sp[4 * LDC], sp[5 * LDC]), pack2(sp[6 * LDC], sp[7 * LDC]));
      }
    } else if (nt == 36) {
      if (half == 0) {
        const float4* s4 = (const float4*)(sC + row * LDC);
        float4* dst = (float4*)((float*)(ws + OFF_GLR) + (size_t)token * 32);
#pragma unroll
        for (int i = 0; i < 8; i++) dst[i] = s4[i];
      }
    } else if (nt >= 20 && nt < 28) {
#pragma unroll 2
      for (int i = 0; i < 8; i++) {
        const int id = i * 256 + tid, th = id >> 10, col = (id >> 3) & 127, tc = id & 7;
        const float* sp = sC + (th * 64 + tc * 8) * LDC + col;
        *(uint4*)((u16*)(ws + OFF_GV) + ((size_t)((t0 >> 6) + th) * 1024 + (nt - 20) * 128 + col) * 64 + tc * 8) =
            make_uint4(pack2(sp[0], sp[LDC]), pack2(sp[2 * LDC], sp[3 * LDC]), pack2(sp[4 * LDC], sp[5 * LDC]), pack2(sp[6 * LDC], sp[7 * LDC]));
      }
    } else {
      u16* dst; size_t rstride; int mode;
      if (nt < 16) { dst = (u16*)(ws + OFF_GQ) + (size_t)t0 * 512 + (nt - 12) * 128; rstride = 512; mode = 1; }
      else if (nt < 20) { dst = (u16*)(ws + OFF_GK) + (size_t)t0 * 512 + (nt - 16) * 128; rstride = 512; mode = 0; }
      else if (nt < 36) { dst = (u16*)(ws + OFF_GOUT) + (size_t)t0 * 1024 + (nt - 28) * 128; rstride = 1024; mode = 0; }
      else { dst = (u16*)(ws + OFF_GM) + (size_t)t0 * 2048 + (nt - 37) * 128; rstride = 2048; mode = 2; }
#pragma unroll 2
      for (int i = 0; i < 8; i++) {
        const int id = i * 256 + tid, rr = id >> 4, c8 = (id & 15) * 8;
        float4 a = *(const float4*)(sC + rr * LDC + c8), b2 = *(const float4*)(sC + rr * LDC + c8 + 4);
        if (mode == 1) { a.x *= 0.08838834764831845f; a.y *= 0.08838834764831845f; a.z *= 0.08838834764831845f; a.w *= 0.08838834764831845f;
                         b2.x *= 0.08838834764831845f; b2.y *= 0.08838834764831845f; b2.z *= 0.08838834764831845f; b2.w *= 0.08838834764831845f; }
        if (mode == 2) { a.x = sigmoidf_(a.x); a.y = sigmoidf_(a.y); a.z = sigmoidf_(a.z); a.w = sigmoidf_(a.w);
                         b2.x = sigmoidf_(b2.x); b2.y = sigmoidf_(b2.y); b2.z = sigmoidf_(b2.z); b2.w = sigmoidf_(b2.w); }
        *(uint4*)(dst + (size_t)rr * rstride + c8) = make_uint4(pack2(a.x, a.y), pack2(a.z, a.w), pack2(b2.x, b2.y), pack2(b2.z, b2.w));
      }
    }
  }
}

__device__ __forceinline__ void attn_item(const Params& p, int l, int item, char* smem) {
  char* ws = p.ws;
  const int tid = threadIdx.x, lane = tid & 63, w = tid >> 6, r16 = lane & 15, quad = lane >> 4;
  int tok0, h, qb, nkeys, vstride; const u16* kptr; const u16* vptr;
  if (item < 512) {
    const int b = item >> 7; h = (item >> 3) & 15; qb = item & 7; tok0 = NCTX + b * 1024; nkeys = LKEYS; vstride = LKEYS;
    kptr = (const u16*)(ws + OFF_KL) + ((size_t)l * 4 + b) * LKEYS * 256 + (h >> 2) * 64;
    vptr = (const u16*)(ws + OFF_VTL) + (((size_t)l * 4 + b) * 4 + (h >> 2)) * 64 * LKEYS;
  } else {
    const int it = item - 512; const int b = it >> 5; h = (it >> 1) & 15; qb = it & 1; tok0 = b * 256; nkeys = 256; vstride = 256;
    kptr = (const u16*)(ws + OFF_KC) + (size_t)b * 256 * 256 + (h >> 2) * 64;
    vptr = (const u16*)(ws + OFF_VTC) + ((size_t)b * 4 + (h >> 2)) * 64 * 256;
  }
  const int qrow0 = tok0 + qb * 128 + w * 32;
  const u16* qptr = (const u16*)(ws + OFF_Q) + (size_t)qrow0 * 1024 + h * 64;
  bf16x8 qf[2][2];
#pragma unroll
  for (int qt = 0; qt < 2; qt++)
#pragma unroll
    for (int dh = 0; dh < 2; dh++) qf[qt][dh] = ld8(qptr + (size_t)(qt * 16 + r16) * 1024 + dh * 32 + quad * 8);
  f32x4 o[4][2];
#pragma unroll
  for (int dt = 0; dt < 4; dt++) { o[dt][0] = (f32x4){0, 0, 0, 0}; o[dt][1] = (f32x4){0, 0, 0, 0}; }
  float mrow[2] = {-1e30f, -1e30f}, lrow[2] = {0.f, 0.f};
  const int lr = tid >> 3, lc = (tid & 7) * 8;
  u32x4 rk[2], rv[2];
  const int nkb = nkeys >> 6;
#define AT_LOAD(KB) { _Pragma("unroll") for (int i = 0; i < 2; i++) { \
      rk[i] = *(const u32x4*)(kptr + (size_t)((KB) * 64 + lr + 32 * i) * 256 + lc); \
      rv[i] = *(const u32x4*)(vptr + (size_t)(lr + 32 * i) * vstride + (KB) * 64 + lc); } }
#define AT_STORE(BUF) { u16* _k = sK0 + (BUF) * (128 * LDT); _Pragma("unroll") for (int i = 0; i < 2; i++) { *(u32x4*)(_k + (lr + 32 * i) * LDT + lc) = rk[i]; *(u32x4*)(_k + 64 * LDT + (lr + 32 * i) * LDT + lc) = rv[i]; } }
  u16* const sK0 = (u16*)smem;
  AT_LOAD(0);
  __syncthreads();
  AT_STORE(0);
  AT_LOAD(1);
  __syncthreads();
  for (int kb = 0; kb < nkb; kb++) {
    AT_STORE((kb + 1) & 1);
    { const int kn = min(kb + 2, nkb - 1); AT_LOAD(kn); }
    const u16* sK = sK0 + (kb & 1) * (128 * LDT);
    const u16* sV = sK + 64 * LDT;
    f32x4 st[4][2];
#pragma unroll
    for (int kt = 0; kt < 4; kt++) {
      const bf16x8 k0 = ld8(sK + (kt * 16 + r16) * LDT + quad * 8), k1 = ld8(sK + (kt * 16 + r16) * LDT + 32 + quad * 8);
#pragma unroll
      for (int qt = 0; qt < 2; qt++) {
        f32x4 z = (f32x4){0, 0, 0, 0};
        z = MFMA16(k0, qf[qt][0], z);
        z = MFMA16(k1, qf[qt][1], z);
        st[kt][qt] = z;
      }
    }
    bf16x8 pb[2][2];
#pragma unroll
    for (int qt = 0; qt < 2; qt++) {
      float mx = -1e30f;
#pragma unroll
      for (int kt = 0; kt < 4; kt++)
#pragma unroll
        for (int e = 0; e < 4; e++) { st[kt][qt][e] *= 1.4426950408889634f; mx = fmaxf(mx, st[kt][qt][e]); }
      mx = fmaxf(mx, __shfl_xor(mx, 16)); mx = fmaxf(mx, __shfl_xor(mx, 32));
      const float mn = fmaxf(mrow[qt], mx);
      const float alpha = __builtin_amdgcn_exp2f(mrow[qt] - mn);
      mrow[qt] = mn;
      float rs = 0;
#pragma unroll
      for (int kt = 0; kt < 4; kt++)
#pragma unroll
        for (int e = 0; e < 4; e++) { const float pv = __builtin_amdgcn_exp2f(st[kt][qt][e] - mn); st[kt][qt][e] = pv; rs += pv; }
      lrow[qt] = lrow[qt] * alpha + rs;
#pragma unroll
      for (int dt = 0; dt < 4; dt++) o[dt][qt] *= alpha;
#pragma unroll
      for (int kh = 0; kh < 2; kh++) {
        uint4 u = make_uint4(pack2(st[2 * kh][qt][0], st[2 * kh][qt][1]), pack2(st[2 * kh][qt][2], st[2 * kh][qt][3]),
                             pack2(st[2 * kh + 1][qt][0], st[2 * kh + 1][qt][1]), pack2(st[2 * kh + 1][qt][2], st[2 * kh + 1][qt][3]));
        pb[qt][kh] = __builtin_bit_cast(bf16x8, u);
      }
    }
#pragma unroll
    for (int dt = 0; dt < 4; dt++)
#pragma unroll
      for (int kh = 0; kh < 2; kh++) {
        const u16* vp = sV + (dt * 16 + r16) * LDT + kh * 32 + quad * 4;
        const bf16x8 vf = mk8(*(const uint2*)vp, *(const uint2*)(vp + 16));
        o[dt][0] = MFMA16(vf, pb[0][kh], o[dt][0]);
        o[dt][1] = MFMA16(vf, pb[1][kh], o[dt][1]);
      }
    __syncthreads();
  }
#undef AT_LOAD
#undef AT_STORE
  u16* att = (u16*)(ws + OFF_ATT);
#pragma unroll
  for (int qt = 0; qt < 2; qt++) {
    float lt = lrow[qt];
    lt += __shfl_xor(lt, 16); lt += __shfl_xor(lt, 32);
    const float inv = 1.f / lt;
#pragma unroll
    for (int dt = 0; dt < 4; dt++) {
      uint2 u = make_uint2(pack2(o[dt][qt][0] * inv, o[dt][qt][1] * inv), pack2(o[dt][qt][2] * inv, o[dt][qt][3] * inv));
      *(uint2*)(att + (size_t)(qrow0 + qt * 16 + r16) * 1024 + h * 64 + dt * 16 + quad * 4) = u;
    }
  }
}

#define LDQ 136
__device__ __forceinline__ void gla_prep_item(const Params& p, int l, int item, char* smem) {
  char* ws = p.ws;
  u16* sQE = (u16*)smem;
  u16* sKE = sQE + 64 * LDQ;
  u16* sKT = sKE + 64 * LDQ;
  float* sGLR = (float*)(sKT + 128 * LDT);
  float* sTot = sGLR + 1024;
  const int tid = threadIdx.x, lane = tid & 63, w = tid >> 6, r16 = lane & 15, quad = lane >> 4;
  const int c = item >> 3, h = (item >> 1) & 3, dir = item & 1;
  const int tb = c * 64;
  const u16* GQ = (const u16*)(ws + OFF_GQ); const u16* GK = (const u16*)(ws + OFF_GK);
  const float* GLR = (const float*)(ws + OFF_GLR);
  {
    const int tk = tid >> 2, r4 = (tid & 3) * 4;
    *(float4*)(sGLR + tk * 16 + r4) = *(const float4*)(GLR + (size_t)(tb + tk) * 32 + dir * 16 + r4);
#pragma unroll
    for (int i = 0; i < 4; i++) {
      const int ch = tid + 256 * i, rr = ch >> 4, cc = (ch & 15) * 8;
      *(uint4*)(sQE + rr * LDQ + cc) = *(const uint4*)(GQ + (size_t)(tb + rr) * 512 + h * 128 + cc);
      *(uint4*)(sKE + rr * LDQ + cc) = *(const uint4*)(GK + (size_t)(tb + rr) * 512 + h * 128 + cc);
    }
  }
  __syncthreads();
#pragma unroll 1
  for (int dh = 0; dh < 2; dh++) {
    const int dk = dh * 64 + lane, qtr = w;
    float la[16];
    float tot = 0;
    {
      float w2r[16];
#pragma unroll
      for (int r = 0; r < 16; r++) w2r[r] = p.gate_w2[(((size_t)l * 2 + dir) * 16 + r) * 512 + h * 128 + dk];
      const float gb = p.gate_b[((size_t)l * 2 + dir) * 512 + h * 128 + dk];
#pragma unroll
      for (int tt = 0; tt < 16; tt++) {
        const float* g = sGLR + (qtr * 16 + tt) * 16;
        float z = gb;
#pragma unroll
        for (int r = 0; r < 16; r++) z += g[r] * w2r[r];
        const float ls = fminf(z, 0.f) - __logf(1.f + __expf(-fabsf(z)));
        la[tt] = ls * (1.f / 16.f);
        tot += la[tt];
      }
    }
    sTot[qtr * 128 + dk] = tot;
    __syncthreads();
    const float q0 = sTot[dk], q1 = sTot[128 + dk], q2 = sTot[256 + dk], q3 = sTot[384 + dk];
    const float bl = (q0 + q1) + (q2 + q3);
    float run;
    if (dir == 0) {
      run = qtr == 0 ? 0.f : qtr == 1 ? q0 : qtr == 2 ? q0 + q1 : q0 + q1 + q2;
#pragma unroll
      for (int tt = 0; tt < 16; tt++) { run += la[tt]; la[tt] = run; }
    } else {
      run = qtr == 3 ? 0.f : qtr == 2 ? q3 : qtr == 1 ? q3 + q2 : q3 + q2 + q1;
#pragma unroll
      for (int tt = 15; tt >= 0; tt--) { run += la[tt]; la[tt] = run; }
    }
    if (qtr == 0) ((float*)(ws + OFF_EBL))[(size_t)item * 128 + dk] = __expf(bl);
#pragma unroll
    for (int tt = 0; tt < 16; tt++) {
      const int tk = qtr * 16 + tt;
      const float q = bf2f(sQE[tk * LDQ + dk]);
      const float k = bf2f(sKE[tk * LDQ + dk]);
      const float bb = la[tt];
      sQE[tk * LDQ + dk] = f2bf(q * __expf(bb));
      sKE[tk * LDQ + dk] = f2bf(k * __expf(-bb));
      sKT[dk * LDT + tk] = f2bf(k * __expf(bl - bb));
    }
  }
  __syncthreads();
  {
    bf16x8 qb4[4];
#pragma unroll
    for (int ks = 0; ks < 4; ks++) qb4[ks] = ld8(sQE + (w * 16 + r16) * LDQ + ks * 32 + quad * 8);
    u16* PM = (u16*)(ws + OFF_PM) + (size_t)item * 4096;
    const int i = w * 16 + r16;
#pragma unroll
    for (int jt = 0; jt < 4; jt++) {
      f32x4 z = (f32x4){0, 0, 0, 0};
#pragma unroll
      for (int ks = 0; ks < 4; ks++) z = MFMA16(ld8(sKE + (jt * 16 + r16) * LDQ + ks * 32 + quad * 8), qb4[ks], z);
#pragma unroll
      for (int e = 0; e < 4; e++) {
        const int j = jt * 16 + quad * 4 + e;
        const bool keep = dir == 0 ? (j <= i) : (j >= i);
        z[e] = keep ? z[e] : 0.f;
      }
      *(uint2*)(PM + i * 64 + jt * 16 + quad * 4) = make_uint2(pack2(z[0], z[1]), pack2(z[2], z[3]));
    }
  }
  {
    u16* QE = (u16*)(ws + OFF_QE) + (size_t)item * 8192;
    u16* KT = (u16*)(ws + OFF_KT) + (size_t)item * 8192;
#pragma unroll
    for (int i = 0; i < 4; i++) {
      const int ch = tid + 256 * i;
      { const int rr = ch >> 4, cc = (ch & 15) * 8; *(uint4*)(QE + rr * 128 + cc) = *(const uint4*)(sQE + rr * LDQ + cc); }
      { const int rr = ch >> 3, cc = (ch & 7) * 8; *(uint4*)(KT + rr * 64 + cc) = *(const uint4*)(sKT + rr * LDT + cc); }
    }
  }
}

__device__ __forceinline__ void gla_scan_item(const Params& p, int l, int item, char* smem) {
  char* ws = p.ws;
  u16* sST = (u16*)smem;
  const int tid = threadIdx.x, lane = tid & 63, w = tid >> 6, r16 = lane & 15, quad = lane >> 4;
  int b, h, dir, dvs, tok0, nch, grp; bool lat;
  if (item < 512) { lat = true; grp = 3 - (item >> 7); const int it = item & 127; b = it >> 5; h = (it >> 3) & 3; dir = (it >> 2) & 1; dvs = it & 3; tok0 = NCTX + b * 1024; nch = 16; }
  else { const int it = item - 512; lat = false; grp = 0; b = it >> 5; h = (it >> 3) & 3; dir = (it >> 2) & 1; dvs = it & 3; tok0 = b * 256; nch = 4; }
  f32x4 ST[8];
  const size_t sbase = ((((size_t)b * 2 + l) * 2 + dir) * 4 + h) * 128;
  if (lat) {
#pragma unroll
    for (int t = 0; t < 8; t++) {
      const float4 v = *(const float4*)(p.state_gla + (sbase + t * 16 + r16) * 256 + dvs * 64 + w * 16 + quad * 4);
      ST[t] = (f32x4){v.x, v.y, v.z, v.w};
    }
  } else {
#pragma unroll
    for (int t = 0; t < 8; t++) ST[t] = (f32x4){0, 0, 0, 0};
  }
  u16* OUTP = (u16*)(ws + (dir == 0 ? OFF_OF : OFF_OB));
  u16* sKT = sST + 64 * LDQ;
  u16* sGV = sKT + 128 * LDT;
  const int lr = tid >> 3, lc = (tid & 7) * 8;
  u32x4 rkt[4], rgv[2];
#define SC_LOAD(CI) { const int c_ = dir == 0 ? (CI) : nch - 1 - (CI); const int cgl = (tok0 >> 6) + c_; \
    const u16* KT_ = (const u16*)(ws + OFF_KT) + (((size_t)cgl * 4 + h) * 2 + dir) * 8192; \
    const u16* GV_ = (const u16*)(ws + OFF_GV) + ((size_t)cgl * 1024 + h * 256 + dvs * 64) * 64; \
    _Pragma("unroll") for (int i = 0; i < 4; i++) rkt[i] = *(const u32x4*)(KT_ + (lr + 32 * i) * 64 + lc); \
    _Pragma("unroll") for (int i = 0; i < 2; i++) rgv[i] = *(const u32x4*)(GV_ + (lr + 32 * i) * 64 + lc); }
  const int nsteps = grp * 4 + 4;
  SC_LOAD(0);
#pragma unroll 1
  for (int ci = 0; ci < nsteps; ci++) {
    const bool full = ci >= grp * 4;
    const int c = dir == 0 ? ci : nch - 1 - ci;
    const int cg_ = (tok0 >> 6) + c;
    const int tb = cg_ * 64;
    const size_t ip = ((size_t)cg_ * 4 + h) * 2 + dir;
    bf16x8 qb4[4], pbf[2];
    if (full) {
      const u16* QE = (const u16*)(ws + OFF_QE) + ip * 8192;
      const u16* PM = (const u16*)(ws + OFF_PM) + ip * 4096;
#pragma unroll
      for (int ks = 0; ks < 4; ks++) qb4[ks] = ld8(QE + (w * 16 + r16) * 128 + ks * 32 + quad * 8);
#pragma unroll
      for (int kh = 0; kh < 2; kh++) pbf[kh] = ld8(PM + (w * 16 + r16) * 64 + kh * 32 + quad * 8);
    }
    const float* EBL = (const float*)(ws + OFF_EBL) + ip * 128;
    float ebl[8];
#pragma unroll
    for (int t = 0; t < 8; t++) ebl[t] = EBL[t * 16 + r16];
    __syncthreads();
#pragma unroll
    for (int i = 0; i < 4; i++) *(u32x4*)(sKT + (lr + 32 * i) * LDT + lc) = rkt[i];
#pragma unroll
    for (int i = 0; i < 2; i++) *(u32x4*)(sGV + (lr + 32 * i) * LDT + lc) = rgv[i];
    if (full) {
#pragma unroll
      for (int t = 0; t < 8; t++)
#pragma unroll
        for (int e = 0; e < 4; e++) sST[(w * 16 + quad * 4 + e) * LDQ + t * 16 + r16] = f2bf(ST[t][e]);
    }
    __syncthreads();
    { const int cn = min(ci + 1, nsteps - 1); SC_LOAD(cn); }
    const bf16x8 vts0 = ld8(sGV + (w * 16 + r16) * LDT + quad * 8), vts1 = ld8(sGV + (w * 16 + r16) * LDT + 32 + quad * 8);
    if (full) {
#pragma unroll
      for (int dt = 0; dt < 4; dt++) {
        f32x4 oacc = (f32x4){0, 0, 0, 0};
#pragma unroll
        for (int kh = 0; kh < 2; kh++) oacc = MFMA16(ld8(sGV + (dt * 16 + r16) * LDT + kh * 32 + quad * 8), pbf[kh], oacc);
#pragma unroll
        for (int ks = 0; ks < 4; ks++) oacc = MFMA16(ld8(sST + (dt * 16 + r16) * LDQ + ks * 32 + quad * 8), qb4[ks], oacc);
        *(uint2*)(OUTP + (size_t)(tb + w * 16 + r16) * 1024 + h * 256 + dvs * 64 + dt * 16 + quad * 4) = make_uint2(pack2(oacc[0], oacc[1]), pack2(oacc[2], oacc[3]));
      }
    }
#pragma unroll
    for (int t = 0; t < 8; t++) {
      f32x4 z = ST[t] * ebl[t];
      z = MFMA16(vts0, ld8(sKT + (t * 16 + r16) * LDT + quad * 8), z);
      z = MFMA16(vts1, ld8(sKT + (t * 16 + r16) * LDT + 32 + quad * 8), z);
      ST[t] = z;
    }
  }
#undef SC_LOAD
  __syncthreads();
  if (!lat) {
#pragma unroll
    for (int t = 0; t < 8; t++)
      *(float4*)(p.out + OUT_S + (sbase + t * 16 + r16) * 256 + dvs * 64 + w * 16 + quad * 4) = make_float4(ST[t][0], ST[t][1], ST[t][2], ST[t][3]);
  }
}

__device__ __forceinline__ void phase_mixa(const Params& p, int l, char* smem) {
  for (int it = blockIdx.x; it < 512 + 1536; it += gridDim.x) {
    if (it < 512) attn_item(p, l, it, smem); else gla_prep_item(p, l, it - 512, smem);
    __syncthreads();
  }
}
__device__ __forceinline__ void phase_mixb(const Params& p, int l, char* smem) {
  for (int it = blockIdx.x; it < 1536 + 1024; it += gridDim.x) {
    if (it < 1536) gla_scan_item(p, l, it, smem); else attn_item(p, l, it - 1536 + 512, smem);
    __syncthreads();
  }
}

__device__ __forceinline__ void phase_glapost(const Params& p, int l) {
  char* ws = p.ws;
  const int lane = threadIdx.x & 63;
  const int wv = blockIdx.x * 4 + (threadIdx.x >> 6), nw = gridDim.x * 4;
  for (int token = wv; token < NTOK; token += nw) {
    const size_t base = (size_t)token * 1024 + lane * 16;
    const uint4 f0 = *(const uint4*)((u16*)(ws + OFF_OF) + base), f1 = *(const uint4*)((u16*)(ws + OFF_OF) + base + 8);
    const uint4 b0 = *(const uint4*)((u16*)(ws + OFF_OB) + base), b1 = *(const uint4*)((u16*)(ws + OFF_OB) + base + 8);
    const uint4 g0 = *(const uint4*)((u16*)(ws + OFF_GOUT) + base), g1 = *(const uint4*)((u16*)(ws + OFF_GOUT) + base + 8);
    const unsigned fu[8] = {f0.x, f0.y, f0.z, f0.w, f1.x, f1.y, f1.z, f1.w};
    const unsigned bu[8] = {b0.x, b0.y, b0.z, b0.w, b1.x, b1.y, b1.z, b1.w};
    const unsigned gu[8] = {g0.x, g0.y, g0.z, g0.w, g1.x, g1.y, g1.z, g1.w};
    float o[16]; float ss = 0;
#pragma unroll
    for (int i = 0; i < 8; i++) {
      o[2 * i] = bf_lo(fu[i]) + bf_lo(bu[i]); o[2 * i + 1] = bf_hi(fu[i]) + bf_hi(bu[i]);
      ss += o[2 * i] * o[2 * i] + o[2 * i + 1] * o[2 * i + 1];
    }
    ss += __shfl_xor(ss, 1); ss += __shfl_xor(ss, 2); ss += __shfl_xor(ss, 4); ss += __shfl_xor(ss, 8);
    const float r = rsqrtf(ss * (1.f / 256.f) + 1e-6f);
    const float* gn = p.gla_norm + l * 256 + (lane & 15) * 16;
    unsigned ou[8];
#pragma unroll
    for (int i = 0; i < 8; i++) {
      const float a = o[2 * i] * r * gn[2 * i] * siluf_(bf_lo(gu[i]));
      const float b = o[2 * i + 1] * r * gn[2 * i + 1] * siluf_(bf_hi(gu[i]));
      ou[i] = pack2(a, b);
    }
    *(uint4*)((u16*)(ws + OFF_OF) + base) = make_uint4(ou[0], ou[1], ou[2], ou[3]);
    *(uint4*)((u16*)(ws + OFF_OF) + base + 8) = make_uint4(ou[4], ou[5], ou[6], ou[7]);
  }
}

__device__ __forceinline__ void phase_gemm_ao(const Params& p, int l, char* smem) {
  char* ws = p.ws;
  u16* sA = (u16*)smem; u16* sB = sA + 128 * LDT; float* sC = (float*)smem;
  const int tid = threadIdx.x, lane = tid & 63, wid = tid >> 6, wr = wid >> 1, wc = wid & 1, r16 = lane & 15, quad = lane >> 4;
  const u16* GM = (const u16*)(ws + OFF_GM);
  for (int q = blockIdx.x >> 3; ; q += gridDim.x >> 3) {
    int mt, nt; if (!xcd_tile(q, 8, mt, nt)) break;
    const int t0 = mt * 128, n0 = nt * 128;
    f32x4 acc[4][4]; acc_zero(acc);
    gemm_tile2(acc, (const u16*)(ws + OFF_ATT) + (size_t)t0 * 1024, 1024, (const u16*)(ws + OFF_WAOT) + ((size_t)l * 1024 + n0) * 1024, 1024, 1024, sA);
    acc_to_lds(acc, sC);
#pragma unroll 2
    for (int i = 0; i < 8; i++) {
      const int id = i * 256 + tid, row = id >> 4, c8 = (id & 15) * 8;
      const u16* gp = GM + (size_t)(t0 + row) * 2048 + n0 + c8;
      const uint4 ga = *(const uint4*)gp, gg = *(const uint4*)(gp + 1024);
      float4* sp = (float4*)(sC + row * LDC + c8);
      float4 a = sp[0], b = sp[1];
      a.x *= bf_lo(ga.x) / bf_lo(gg.x); a.y *= bf_hi(ga.x) / bf_hi(gg.x); a.z *= bf_lo(ga.y) / bf_lo(gg.y); a.w *= bf_hi(ga.y) / bf_hi(gg.y);
      b.x *= bf_lo(ga.z) / bf_lo(gg.z); b.y *= bf_hi(ga.z) / bf_hi(gg.z); b.z *= bf_lo(ga.w) / bf_lo(gg.w); b.w *= bf_hi(ga.w) / bf_hi(gg.w);
      sp[0] = a; sp[1] = b;
    }
    __syncthreads();
#pragma unroll
    for (int i = 0; i < 4; i++)
#pragma unroll
      for (int j = 0; j < 4; j++)
#pragma unroll
        for (int e = 0; e < 4; e++) acc[i][j][e] = sC[(wr * 64 + i * 16 + quad * 4 + e) * LDC + wc * 64 + j * 16 + r16];
    gemm_tile2(acc, (const u16*)(ws + OFF_OF) + (size_t)t0 * 1024, 1024, (const u16*)(ws + OFF_WGOT) + ((size_t)l * 1024 + n0) * 1024, 1024, 1024, sA);
    acc_to_lds(acc, sC);
#pragma unroll 2
    for (int i = 0; i < 8; i++) {
      const int id = i * 256 + tid, row = id >> 4, c8 = (id & 15) * 8, token = t0 + row;
      const uint4 gg = *(const uint4*)(GM + (size_t)token * 2048 + 1024 + n0 + c8);
      const float4 a = *(const float4*)(sC + row * LDC + c8), b = *(const float4*)(sC + row * LDC + c8 + 4);
      *(uint4*)((u16*)(ws + OFF_Q) + (size_t)token * 1024 + n0 + c8) =
          make_uint4(pack2(a.x * bf_lo(gg.x), a.y * bf_hi(gg.x)), pack2(a.z * bf_lo(gg.y), a.w * bf_hi(gg.y)),
                     pack2(b.x * bf_lo(gg.z), b.y * bf_hi(gg.z)), pack2(b.z * bf_lo(gg.w), b.w * bf_hi(gg.w)));
    }
  }
}

__device__ __forceinline__ void phase_gemm_out(const Params& p, int l, char* smem) {
  char* ws = p.ws;
  u16* sA = (u16*)smem; u16* sB = sA + 128 * LDT; float* sC = (float*)smem;
  const int tid = threadIdx.x;
  const float* mod = (const float*)(ws + OFF_MOD) + (size_t)l * 5 * 6144;
  for (int q = blockIdx.x >> 3; ; q += gridDim.x >> 3) {
    int mt, nt; if (!xcd_tile(q, 8, mt, nt)) break;
    const int t0 = mt * 128, n0 = nt * 128;
    f32x4 acc[4][4]; acc_zero(acc);
    gemm_tile2(acc, (const u16*)(ws + OFF_Q) + (size_t)t0 * 1024, 1024, (const u16*)(ws + OFF_WOUT) + ((size_t)l * 1024 + n0) * 1024, 1024, 1024, sA);
    acc_to_lds(acc, sC);
#pragma unroll 4
    for (int i = 0; i < 16; i++) {
      const int id = i * 256 + tid, row = id >> 5, c4 = (id & 31) * 4, token = t0 + row;
      const float4 v = *(const float4*)(sC + row * LDC + c4);
      const float* xsrc = l == 0 ? (token < NCTX ? p.x_prompt + (size_t)token * 1024 : p.x_sample + (size_t)(token - NCTX) * 1024)
                                 : (const float*)(ws + OFF_X) + (size_t)token * 1024;
      const f32x4 xv = __builtin_nontemporal_load((const f32x4*)(xsrc + n0 + c4)); const float4 x = make_float4(xv.x, xv.y, xv.z, xv.w);
      const float4 g = *(const float4*)(mod + (size_t)tok_group(token) * 6144 + 2048 + n0 + c4);
      *(float4*)((float*)(ws + OFF_PRE) + (size_t)token * 1024 + n0 + c4) =
          make_float4(ALPHA * x.x + g.x * v.x, ALPHA * x.y + g.y * v.y, ALPHA * x.z + g.z * v.z, ALPHA * x.w + g.w * v.w);
    }
  }
}

__device__ __forceinline__ void phase_ln1(const Params& p, int l) {
  char* ws = p.ws;
  const int lane = threadIdx.x & 63;
  const int wv = blockIdx.x * 4 + (threadIdx.x >> 6), nw = gridDim.x * 4;
  const float* mod = (const float*)(ws + OFF_MOD) + (size_t)l * 5 * 6144;
  for (int token = wv; token < NTOK; token += nw) {
    float* row = (float*)(ws + OFF_PRE) + (size_t)token * 1024;
    float4 v[4]; float s = 0;
#pragma unroll
    for (int i = 0; i < 4; i++) { const f32x4 t = __builtin_nontemporal_load((const f32x4*)row + i * 64 + lane); v[i] = make_float4(t.x, t.y, t.z, t.w); s += v[i].x + v[i].y + v[i].z + v[i].w; }
    const float mu = wave_sum(s) * (1.f / 1024.f);
    float q = 0;
#pragma unroll
    for (int i = 0; i < 4; i++) { v[i].x -= mu; v[i].y -= mu; v[i].z -= mu; v[i].w -= mu; q += v[i].x * v[i].x + v[i].y * v[i].y + v[i].z * v[i].z + v[i].w * v[i].w; }
    const float rstd = rsqrtf(wave_sum(q) * (1.f / 1024.f) + 1e-5f);
    const float* m = mod + (size_t)tok_group(token) * 6144;
#pragma unroll
    for (int i = 0; i < 4; i++) {
      const int c = i * 256 + lane * 4;
      const float4 g = *(const float4*)(p.ln1_g + l * 1024 + c), bb = *(const float4*)(p.ln1_b + l * 1024 + c);
      float4 x; x.x = v[i].x * rstd * g.x + bb.x; x.y = v[i].y * rstd * g.y + bb.y; x.z = v[i].z * rstd * g.z + bb.z; x.w = v[i].w * rstd * g.w + bb.w;
      ((float4*)row)[i * 64 + lane] = x;
      const float4 sh = *(const float4*)(m + 3072 + c), sc = *(const float4*)(m + 4096 + c);
      *(uint2*)((u16*)(ws + OFF_H) + (size_t)token * 1024 + c) =
          make_uint2(pack2(x.x * (1.f + sc.x) + sh.x, x.y * (1.f + sc.y) + sh.y), pack2(x.z * (1.f + sc.z) + sh.z, x.w * (1.f + sc.w) + sh.w));
    }
  }
}

__device__ __forceinline__ int enc_key(float f) { const int b = __float_as_int(f); return b ^ ((b >> 31) & 0x7fffffff); }
__device__ __forceinline__ float dec_key(int s) { return __int_as_float(s ^ ((s >> 31) & 0x7fffffff)); }
#define CE_DESC(a, b) { const int _mx = max(a, b), _mn = min(a, b); a = _mx; b = _mn; }
__device__ __forceinline__ void sort16_desc(int (&k)[16]) {
#pragma unroll
  for (int size = 2; size <= 16; size <<= 1)
#pragma unroll
    for (int stride = size >> 1; stride > 0; stride >>= 1)
#pragma unroll
      for (int i = 0; i < 16; i++) {
        const int j = i ^ stride;
        if (j > i) { if ((i & size) == 0) { CE_DESC(k[i], k[j]); } else { CE_DESC(k[j], k[i]); } }
      }
}
__device__ __forceinline__ void bitonic_merge16_desc(int (&k)[16]) {
#pragma unroll
  for (int stride = 8; stride > 0; stride >>= 1)
#pragma unroll
    for (int i = 0; i < 16; i++) { const int j = i ^ stride; if (j > i) { CE_DESC(k[i], k[j]); } }
}
__device__ __forceinline__ void merge_top16(int (&a)[16], const int (&b)[16]) {
#pragma unroll
  for (int i = 0; i < 16; i++) a[i] = max(a[i], b[15 - i]);
  bitonic_merge16_desc(a);
}

__device__ __forceinline__ void phase_peerq(const Params& p, int l, char* smem) {
  char* ws = p.ws;
  u16* sA = (u16*)smem; u16* sB = sA + 128 * LDT; float* sC = (float*)smem;
  u16* sQ = (u16*)smem; u16* sS = sQ + 128 * LDQ;
  const int tid = threadIdx.x, lane = tid & 63, wid = tid >> 6, wr = wid >> 1, wc = wid & 1, r16 = lane & 15, quad = lane >> 4;
  int* S1 = (int*)(ws + OFF_S1);
  for (int q = blockIdx.x >> 3; ; q += gridDim.x >> 3) {
    int mt, hd; if (!xcd_tile(q, 8, mt, hd)) break;
    const int t0 = mt * 128;
#pragma unroll 1
    for (int pp = 0; pp < 2; pp++) {
      f32x4 acc[4][4]; acc_zero(acc);
      gemm_tile1(acc, (const u16*)(ws + OFF_H) + (size_t)t0 * 1024, 1024,
                (const u16*)(ws + OFF_WQT) + ((size_t)l * 2048 + hd * 256 + pp * 128) * 1024, 1024, 1024, sA, sB);
      __syncthreads();
#pragma unroll
      for (int i = 0; i < 4; i++)
#pragma unroll
        for (int j = 0; j < 4; j++)
#pragma unroll
          for (int e = 0; e < 4; e++) sQ[(wr * 64 + i * 16 + quad * 4 + e) * LDQ + wc * 64 + j * 16 + r16] = f2bf(acc[i][j][e]);
      {
        const u16* sk = (const u16*)(ws + OFF_SKB) + ((size_t)l * 2 + pp) * 16384;
#pragma unroll
        for (int i = 0; i < 8; i++) {
          const int ch = tid + 256 * i, rr = ch >> 4, cc = (ch & 15) * 8;
          *(uint4*)(sS + rr * LDQ + cc) = *(const uint4*)(sk + rr * 128 + cc);
        }
      }
      __syncthreads();
      acc_zero(acc);
#pragma unroll
      for (int ks = 0; ks < 4; ks++) {
        bf16x8 a[4], b[4];
#pragma unroll
        for (int i = 0; i < 4; i++) a[i] = ld8(sQ + (wr * 64 + i * 16 + r16) * LDQ + ks * 32 + quad * 8);
#pragma unroll
        for (int j = 0; j < 4; j++) b[j] = ld8(sS + (wc * 64 + j * 16 + r16) * LDQ + ks * 32 + quad * 8);
#pragma unroll
        for (int i = 0; i < 4; i++)
#pragma unroll
          for (int j = 0; j < 4; j++) acc[i][j] = MFMA16(a[i], b[j], acc[i][j]);
      }
      acc_to_lds(acc, sC);
#pragma unroll 1
      for (int pass = 0; pass < 4; pass++) {
        const int row = pass * 32 + (tid >> 3), s = tid & 7;
        int k[16];
#pragma unroll
        for (int i = 0; i < 16; i++) { const int col = s + 8 * i; k[i] = (enc_key(sC[row * LDC + col]) & ~127) | col; }
        sort16_desc(k);
#pragma unroll
        for (int m = 1; m <= 4; m <<= 1) {
          int o[16];
#pragma unroll
          for (int i = 0; i < 16; i++) o[i] = __shfl_xor(k[i], m);
          merge_top16(k, o);
        }
        if (s == 0) {
          int4* dst = (int4*)(S1 + (((size_t)(t0 + row) * 8 + hd) * 2 + pp) * 16);
          dst[0] = make_int4(k[0], k[1], k[2], k[3]); dst[1] = make_int4(k[4], k[5], k[6], k[7]);
          dst[2] = make_int4(k[8], k[9], k[10], k[11]); dst[3] = make_int4(k[12], k[13], k[14], k[15]);
        }
      }
    }
    __threadfence_block();
    __syncthreads();
    if (tid < 128) {
      const int token = t0 + tid;
      const int* l1 = S1 + (((size_t)token * 8 + hd) * 2) * 16; const int* l2 = l1 + 16;
      int k1[16], k2[16];
#pragma unroll
      for (int i = 0; i < 4; i++) {
        const int4 a = ((const int4*)l1)[i], b = ((const int4*)l2)[i];
        k1[4 * i] = a.x; k1[4 * i + 1] = a.y; k1[4 * i + 2] = a.z; k1[4 * i + 3] = a.w;
        k2[4 * i] = b.x; k2[4 * i + 1] = b.y; k2[4 * i + 2] = b.z; k2[4 * i + 3] = b.w;
      }
      float v1[16], v2[16];
#pragma unroll
      for (int i = 0; i < 16; i++) { v1[i] = dec_key(k1[i] & ~127); v2[i] = dec_key(k2[i] & ~127); }
#define FILL_GROUP(G, ARR) { int n = 0; _Pragma("unroll") for (int i = 0; i < 16; i++) _Pragma("unroll") for (int j = 0; j < 16; j++) \
        if ((i + 1) * (j + 1) <= 16) { if (n >= (G) * 16 && n < (G) * 16 + 16) ARR[n - (G) * 16] = (enc_key(v1[i] + v2[j]) & ~255) | (i << 4) | j; n++; } \
        _Pragma("unroll") for (int q = 0; q < 16; q++) if ((G) * 16 + q >= 50) ARR[q] = (int)0x80000000; }
      int g0[16], g2[16];
      {
        int g1[16];
        FILL_GROUP(0, g0); sort16_desc(g0);
        FILL_GROUP(1, g1); sort16_desc(g1);
        merge_top16(g0, g1);
      }
      {
        int g3[16];
        FILL_GROUP(2, g2); sort16_desc(g2);
        FILL_GROUP(3, g3); sort16_desc(g3);
        merge_top16(g2, g3);
      }
      merge_top16(g0, g2);
#undef FILL_GROUP
      float sc[16]; float mx = dec_key(g0[0] & ~255), sum = 0;
#pragma unroll
      for (int i = 0; i < 16; i++) { sc[i] = __expf(dec_key(g0[i] & ~255) - mx); sum += sc[i]; }
      const float inv = 1.f / sum;
      int* ei = (int*)(ws + OFF_EI) + (size_t)token * 128 + hd * 16;
      float* eg = (float*)(ws + OFF_EG) + (size_t)token * 128 + hd * 16;
      int eiv[16]; float egv[16];
#pragma unroll
      for (int i = 0; i < 16; i++) {
        const int ci = g0[i] & 255;
        const int i1 = l1[ci >> 4] & 127, i2 = l2[ci & 15] & 127;
        eiv[i] = i1 * 128 + i2;
        egv[i] = sc[i] * inv;
      }
#pragma unroll
      for (int i = 0; i < 4; i++) {
        ((int4*)ei)[i] = make_int4(eiv[4 * i], eiv[4 * i + 1], eiv[4 * i + 2], eiv[4 * i + 3]);
        ((float4*)eg)[i] = make_float4(egv[4 * i], egv[4 * i + 1], egv[4 * i + 2], egv[4 * i + 3]);
      }
    }
    __syncthreads();
  }
}

typedef __attribute__((ext_vector_type(2))) float f32x2v;
#define CV8LO(word) __builtin_amdgcn_cvt_pk_f32_fp8((int)(word), false)
#define CV8HI(word) __builtin_amdgcn_cvt_pk_f32_fp8((int)(word), true)
__device__ __forceinline__ float dot16_fp8(const f32x2v (&hx)[8], const u32x4 r) {
  f32x2v s = CV8LO(r.x) * hx[0];
  s = CV8HI(r.x) * hx[1] + s;
  s = CV8LO(r.y) * hx[2] + s; s = CV8HI(r.y) * hx[3] + s;
  s = CV8LO(r.z) * hx[4] + s; s = CV8HI(r.z) * hx[5] + s;
  s = CV8LO(r.w) * hx[6] + s; s = CV8HI(r.w) * hx[7] + s;
  return s.x + s.y;
}
__device__ __forceinline__ float transpose_reduce64(float (&s)[64], int lane) {
#pragma unroll
  for (int m = 32; m >= 1; m >>= 1) {
    const bool up = (lane & m) != 0;
#pragma unroll
    for (int i = 0; i < m; i++) {
      const float a = s[i], b = s[i + m];
      const float send = up ? a : b, keep = up ? b : a;
      s[i] = keep + __shfl_xor(send, m);
    }
  }
  return s[0];
}
__device__ __forceinline__ void phase_peer_apply(const Params& p, int l) {
  char* ws = p.ws;
  const int lane = threadIdx.x & 63;
  const int wv = blockIdx.x * 4 + (threadIdx.x >> 6), nw = gridDim.x * 4;
  const unsigned char* U = (const unsigned char*)(ws + OFF_U16) + (size_t)l * 16384 * 1024;
  const unsigned char* V = (const unsigned char*)(ws + OFF_V16) + (size_t)l * 16384 * 1024;
  const float* mod = (const float*)(ws + OFF_MOD) + (size_t)l * 5 * 6144;
  for (int token = wv; token < NTOK; token += nw) {
    const u16* hrow = (const u16*)(ws + OFF_H) + (size_t)token * 1024 + lane * 16;
    f32x2v hx[8];
    {
      const uint4 a = *(const uint4*)(hrow), b = *(const uint4*)(hrow + 8);
      hx[0] = (f32x2v){bf_lo(a.x), bf_hi(a.x)}; hx[1] = (f32x2v){bf_lo(a.y), bf_hi(a.y)}; hx[2] = (f32x2v){bf_lo(a.z), bf_hi(a.z)}; hx[3] = (f32x2v){bf_lo(a.w), bf_hi(a.w)};
      hx[4] = (f32x2v){bf_lo(b.x), bf_hi(b.x)}; hx[5] = (f32x2v){bf_lo(b.y), bf_hi(b.y)}; hx[6] = (f32x2v){bf_lo(b.z), bf_hi(b.z)}; hx[7] = (f32x2v){bf_lo(b.w), bf_hi(b.w)};
    }
    const int e0 = ((const int*)(ws + OFF_EI))[(size_t)token * 128 + lane], e1 = ((const int*)(ws + OFF_EI))[(size_t)token * 128 + 64 + lane];
    const float g0 = ((const float*)(ws + OFF_EG))[(size_t)token * 128 + lane], g1 = ((const float*)(ws + OFF_EG))[(size_t)token * 128 + 64 + lane];
    float a0, a1;
    {
      float s[64];
#pragma unroll
      for (int k = 0; k < 64; k++) {
        const int e = __builtin_amdgcn_readlane(e0, k);
        s[k] = dot16_fp8(hx, *(const u32x4*)(U + (size_t)e * 1024 + lane * 16));
      }
      a0 = transpose_reduce64(s, lane) * (1.f / 128.f);
#pragma unroll
      for (int k = 0; k < 64; k++) {
        const int e = __builtin_amdgcn_readlane(e1, k);
        s[k] = dot16_fp8(hx, *(const u32x4*)(U + (size_t)e * 1024 + lane * 16));
      }
      a1 = transpose_reduce64(s, lane) * (1.f / 128.f);
    }
    const float w0 = g0 * geluf_(a0) * (1.f / 16.f), w1 = g1 * geluf_(a1) * (1.f / 16.f);
    f32x2v acc2[8];
#pragma unroll
    for (int i = 0; i < 8; i++) acc2[i] = (f32x2v){0.f, 0.f};
#pragma unroll 8
    for (int k = 0; k < 128; k++) {
      const int e = __builtin_amdgcn_readlane(k < 64 ? e0 : e1, k & 63);
      const float wk = __builtin_bit_cast(float, __builtin_amdgcn_readlane(__builtin_bit_cast(int, k < 64 ? w0 : w1), k & 63));
      const f32x2v wk2 = (f32x2v){wk, wk};
      const u32x4 r = *(const u32x4*)(V + (size_t)e * 1024 + lane * 16);
      acc2[0] = CV8LO(r.x) * wk2 + acc2[0]; acc2[1] = CV8HI(r.x) * wk2 + acc2[1];
      acc2[2] = CV8LO(r.y) * wk2 + acc2[2]; acc2[3] = CV8HI(r.y) * wk2 + acc2[3];
      acc2[4] = CV8LO(r.z) * wk2 + acc2[4]; acc2[5] = CV8HI(r.z) * wk2 + acc2[5];
      acc2[6] = CV8LO(r.w) * wk2 + acc2[6]; acc2[7] = CV8HI(r.w) * wk2 + acc2[7];
    }
    float acc[16];
#pragma unroll
    for (int i = 0; i < 8; i++) { acc[2 * i] = acc2[i].x; acc[2 * i + 1] = acc2[i].y; }
    const float* x1 = (const float*)(ws + OFF_PRE) + (size_t)token * 1024 + lane * 16;
    const float* m = mod + (size_t)tok_group(token) * 6144 + lane * 16;
    float v[16]; float sm = 0;
#pragma unroll
    for (int q = 0; q < 4; q++) {
      const float4 x = *(const float4*)(x1 + q * 4), g = *(const float4*)(m + 5120 + q * 4);
      v[q * 4 + 0] = ALPHA * x.x + g.x * acc[q * 4 + 0]; v[q * 4 + 1] = ALPHA * x.y + g.y * acc[q * 4 + 1];
      v[q * 4 + 2] = ALPHA * x.z + g.z * acc[q * 4 + 2]; v[q * 4 + 3] = ALPHA * x.w + g.w * acc[q * 4 + 3];
    }
#pragma unroll
    for (int i = 0; i < 16; i++) sm += v[i];
    const float mu = wave_sum(sm) * (1.f / 1024.f);
    float q2 = 0;
#pragma unroll
    for (int i = 0; i < 16; i++) { v[i] -= mu; q2 += v[i] * v[i]; }
    const float rstd = rsqrtf(wave_sum(q2) * (1.f / 1024.f) + 1e-5f);
    float* xo = (l == 1 ? p.out + OUT_Y : (float*)(ws + OFF_X)) + (size_t)token * 1024 + lane * 16;
    const float* mn = (const float*)(ws + OFF_MOD) + (size_t)5 * 6144 + (size_t)tok_group(token) * 6144 + lane * 16;
    unsigned hw[8];
#pragma unroll
    for (int q = 0; q < 4; q++) {
      const float4 g = *(const float4*)(p.ln2_g + l * 1024 + lane * 16 + q * 4), bb = *(const float4*)(p.ln2_b + l * 1024 + lane * 16 + q * 4);
      float4 x;
      x.x = v[q * 4 + 0] * rstd * g.x + bb.x; x.y = v[q * 4 + 1] * rstd * g.y + bb.y;
      x.z = v[q * 4 + 2] * rstd * g.z + bb.z; x.w = v[q * 4 + 3] * rstd * g.w + bb.w;
      *(float4*)(xo + q * 4) = x;
      if (l == 0) {
        const float4 sh = *(const float4*)(mn + q * 4), sc = *(const float4*)(mn + 1024 + q * 4);
        hw[q * 2] = pack2(x.x * (1.f + sc.x) + sh.x, x.y * (1.f + sc.y) + sh.y);
        hw[q * 2 + 1] = pack2(x.z * (1.f + sc.z) + sh.z, x.w * (1.f + sc.w) + sh.w);
      }
    }
    if (l == 0) {
      u16* hd = (u16*)(ws + OFF_H) + (size_t)token * 1024 + lane * 16;
      *(uint4*)hd = make_uint4(hw[0], hw[1], hw[2], hw[3]);
      *(uint4*)(hd + 8) = make_uint4(hw[4], hw[5], hw[6], hw[7]);
    }
  }
}

__global__ void __launch_bounds__(256, 2) mega(Params p, int ph_lo, int ph_hi, int coop, int never) {
  extern __shared__ __attribute__((aligned(16))) char smem[];
  __shared__ uint4 xb_words;
  XcdBarrier xb;
  if (coop) {
    if (threadIdx.x == 0) xb_words = make_uint4(0u, 0u, 0u, 0u);
    __syncthreads();
    xb = xcd_barrier_post((unsigned*)(p.ws + OFF_BAR), (volatile LAS unsigned*)&xb_words);
    if (never) cg::this_grid().sync();
  }
#define RUN(PH, CALL) if (ph_lo <= (PH) && (PH) < ph_hi) { CALL; if (coop && (PH) + 1 < ph_hi) xcd_barrier(xb); }
#define LAYER(L) \
  RUN(2 + 9 * L + 0, phase_gemm1(p, L, smem)) \
  RUN(2 + 9 * L + 1, phase_mixa(p, L, smem)) \
  RUN(2 + 9 * L + 2, phase_mixb(p, L, smem)) \
  RUN(2 + 9 * L + 3, phase_glapost(p, L)) \
  RUN(2 + 9 * L + 4, { phase_gemm_ao(p, L, smem); if (L == 0) conv_peer_table(p, 0, 0); else conv_peer_table(p, 1, 1); }) \
  RUN(2 + 9 * L + 5, { phase_gemm_out(p, L, smem); if (L == 0) { conv_peer_table(p, 1, 0); transpose_layer1_idle(p, smem); } }) \
  RUN(2 + 9 * L + 6, phase_ln1(p, L)) \
  RUN(2 + 9 * L + 7, { phase_peerq(p, L, smem); if (L == 0) conv_peer_table(p, 0, 1); }) \
  RUN(2 + 9 * L + 8, phase_peer_apply(p, L))
  RUN(0, phase_prep(p, smem))
  RUN(1, phase_xin(p))
  LAYER(0)
  LAYER(1)
}

constexpr int SMEM_BYTES = 69632;

extern "C" void kernel_launch(void* const* d_in, const int* in_sizes, int n_in, void* d_out, int out_size, void* d_ws, size_t ws_size,
                              hipStream_t stream) {
  static int grid_blocks = 0;
  if (!grid_blocks) {
    hipFuncSetAttribute((const void*)mega, hipFuncAttributeMaxDynamicSharedMemorySize, SMEM_BYTES);
    int dev = 0, cus = 0, per_cu = 0;
    hipGetDevice(&dev);
    hipDeviceGetAttribute(&cus, hipDeviceAttributeMultiprocessorCount, dev);
    hipOccupancyMaxActiveBlocksPerMultiprocessor(&per_cu, mega, 256, SMEM_BYTES);
    if (per_cu > 2) per_cu = 2;
    if (per_cu < 1) per_cu = 1;
    grid_blocks = (cus * per_cu) & ~7;
  }
  if (ws_size < WS_NEED) { fprintf(stderr, "workspace too small: %zu < %zu\n", ws_size, (size_t)WS_NEED); return; }
  Params p{};
  const float** pp = (const float**)&p;
  for (int i = 0; i < 26; i++) pp[i] = (const float*)d_in[i];
  p.out = (float*)d_out;
  p.ws = (char*)d_ws;
  (void)hipMemsetAsync(d_ws, 0, 16384, stream);
  int ph_lo = 0, ph_hi = NPHASE, coop = 1, never = 0;
  void* args[] = {&p, &ph_lo, &ph_hi, &coop, &never};
  hipError_t e = hipLaunchCooperativeKernel((const void*)mega, dim3(grid_blocks), dim3(256), args, SMEM_BYTES, stream);
  if (e != hipSuccess) fprintf(stderr, "cooperative launch failed: %s (grid %d)\n", hipGetErrorString(e), grid_blocks);
}
```

```cpp
#include <hip/hip_runtime.h>
#include <hip/hip_cooperative_groups.h>
#include <cstdio>
#include <cstdint>
namespace cg = cooperative_groups;

typedef unsigned short u16;
typedef __attribute__((ext_vector_type(8))) short bf16x8;
typedef __attribute__((ext_vector_type(4))) float f32x4;
typedef __attribute__((ext_vector_type(4))) unsigned u32x4;
typedef __attribute__((ext_vector_type(2))) float f32x2_t;
typedef __attribute__((ext_vector_type(2))) __bf16 bf16x2_t;

constexpr int DM = 1024;
constexpr int NTOK = 12288, NCTX = 8192;
constexpr int INW = 6688, INWP = 6784;
constexpr int LKEYS = 1536;
constexpr float ALPHA = 1.4142135623730951f;
constexpr int NPHASE = 20;

constexpr size_t MB = 1024ull * 1024ull;
constexpr size_t OFF_BAR  = 0;
constexpr size_t OFF_WINT = 16384;
constexpr size_t OFF_WAOT = OFF_WINT + 2ull * INWP * 1024 * 2;
constexpr size_t OFF_WGOT = OFF_WAOT + 4 * MB;
constexpr size_t OFF_WOUT = OFF_WGOT + 4 * MB;
constexpr size_t OFF_WQT  = OFF_WOUT + 4 * MB;
constexpr size_t OFF_SKB  = OFF_WQT + 8 * MB;
constexpr size_t OFF_U16  = OFF_SKB + 131072;
constexpr size_t OFF_V16  = OFF_U16 + 32 * MB;
constexpr size_t OFF_MOD  = OFF_V16 + 32 * MB;
constexpr size_t OFF_ROPE = OFF_MOD + 262144;
constexpr size_t OFF_X    = OFF_ROPE + 262144;
constexpr size_t OFF_H    = OFF_X + 48 * MB;
constexpr size_t OFF_Q    = OFF_H + 24 * MB;
constexpr size_t OFF_KC   = OFF_Q + 24 * MB;
constexpr size_t OFF_KL   = OFF_KC + 4 * MB;
constexpr size_t OFF_VTC  = OFF_KL + 6 * MB;
constexpr size_t OFF_VTL  = OFF_VTC + 4 * MB;
constexpr size_t OFF_GQ   = OFF_VTL + 6 * MB;
constexpr size_t OFF_GK   = OFF_GQ + 12 * MB;
constexpr size_t OFF_GV   = OFF_GK + 12 * MB;
constexpr size_t OFF_GOUT = OFF_GV + 24 * MB;
constexpr size_t OFF_GLR  = OFF_GOUT + 24 * MB;
constexpr size_t OFF_GM   = OFF_GLR + 2 * MB;
constexpr size_t OFF_ATT  = OFF_GM + 48 * MB;
constexpr size_t OFF_OF   = OFF_ATT + 24 * MB;
constexpr size_t OFF_OB   = OFF_OF + 24 * MB;
constexpr size_t OFF_KT   = OFF_OB + 24 * MB;
constexpr size_t OFF_PM   = OFF_KT + 24 * MB;
constexpr size_t OFF_EBL  = OFF_PM + 12 * MB;
constexpr size_t WS_NEED  = OFF_EBL + 1 * MB;
constexpr size_t OFF_QE   = OFF_H;
constexpr size_t OFF_PRE  = OFF_GV;
constexpr size_t OFF_S1   = OFF_GM;
constexpr size_t OFF_EI   = OFF_S1 + 13 * MB;
constexpr size_t OFF_EG   = OFF_EI + 6 * MB;

struct Params {
  const float *x_prompt, *x_sample, *cache_k, *cache_v, *state_gla, *c, *c_ctx, *ada_w, *ada_b, *w_in, *q_norm, *k_norm,
      *gate_w2, *gate_b, *gla_norm, *w_attn_o, *w_gla_o, *w_out, *ln1_g, *ln1_b, *ln2_g, *ln2_b, *peer_wq, *peer_sub_keys,
      *peer_u, *peer_v;
  float* out;
  char* ws;
};

constexpr size_t OUT_Y   = 0;
constexpr size_t OUT_K   = (size_t)NTOK * DM;
constexpr size_t OUT_V   = OUT_K + 32ull * 2 * 256 * 256;
constexpr size_t OUT_S   = OUT_V + 32ull * 2 * 256 * 256;

__device__ __forceinline__ unsigned pack2(float lo, float hi) {
  f32x2_t v = {lo, hi};
  bf16x2_t b = __builtin_convertvector(v, bf16x2_t);
  return __builtin_bit_cast(unsigned, b);
}
__device__ __forceinline__ u16 f2bf(float f) { return (u16)(pack2(f, 0.f) & 0xffffu); }
__device__ __forceinline__ float bf2f(u16 h) { return __uint_as_float(((unsigned)h) << 16); }
__device__ __forceinline__ float bf_lo(unsigned u) { return __uint_as_float(u << 16); }
__device__ __forceinline__ float bf_hi(unsigned u) { return __uint_as_float(u & 0xffff0000u); }
__device__ __forceinline__ float sigmoidf_(float x) { return 1.f / (1.f + __expf(-x)); }
__device__ __forceinline__ float siluf_(float x) { return x / (1.f + __expf(-x)); }
__device__ __forceinline__ float geluf_(float x) {
  float u = 0.7978845608028654f * (x + 0.044715f * x * x * x);
  float t = 1.f - 2.f / (1.f + __expf(2.f * u));
  return 0.5f * x * (1.f + t);
}
__device__ __forceinline__ int tok_group(int token) { return token < NCTX ? 0 : 1 + ((token - NCTX) >> 10); }
__device__ __forceinline__ float wave_sum(float v) {
#pragma unroll
  for (int m = 32; m >= 1; m >>= 1) v += __shfl_xor(v, m);
  return v;
}
__device__ __forceinline__ bf16x8 mk8(uint2 a, uint2 b) {
  uint4 u = make_uint4(a.x, a.y, b.x, b.y);
  return __builtin_bit_cast(bf16x8, u);
}
__device__ __forceinline__ bf16x8 ld8(const u16* p) { return *(const bf16x8*)p; }
#define MFMA16(a, b, c) __builtin_amdgcn_mfma_f32_16x16x32_bf16((a), (b), (c), 0, 0, 0)

#define XB_TMO      128
#define XB_XCNT(j)  (256  + 64 * (j))
#define XB_XSUB(j)  (1280 + 64 * (j))
#define XB_XGEN(j)  (2304 + 64 * (j))
#define XB_TOP      3328
#define XB_TOPGEN   3392
#define XCD_BAR_WORDS 3456
#define XB_SPIN_CAP (1u << 22)
#define LAS __attribute__((address_space(3)))
__device__ __forceinline__ unsigned xb_ld(unsigned* p) { return __hip_atomic_load(p, __ATOMIC_RELAXED, __HIP_MEMORY_SCOPE_AGENT); }
__device__ __forceinline__ unsigned xb_add(unsigned* p, unsigned v) { return __hip_atomic_fetch_add(p, v, __ATOMIC_RELAXED, __HIP_MEMORY_SCOPE_AGENT); }
__device__ __forceinline__ unsigned xb_xcc_id() { return (unsigned)__builtin_amdgcn_s_getreg((3 << 11) | 20) & 0xFu; }
#define XB_SPIN(cond, bar) do { unsigned _sp = 0; while (cond) { __builtin_amdgcn_s_sleep(4); \
    if ((++_sp & 255u) == 0u) { if (xb_ld(&(bar)[XB_TMO])) break; if (_sp > XB_SPIN_CAP) { atomicAdd(&(bar)[XB_TMO], 1u); break; } } } } while (0)
struct XcdBarrier { unsigned* bar; unsigned x; volatile LAS unsigned* st; };
__device__ __forceinline__ XcdBarrier xcd_barrier_post(unsigned* bar, volatile LAS unsigned* st) {
  XcdBarrier b; b.bar = bar; b.x = xb_xcc_id(); b.st = st;
  if (threadIdx.x == 0) (void)xb_add(&bar[XB_XCNT(b.x)], 1u);
  return b;
}
__device__ __forceinline__ void xcd_barrier_complete(unsigned* bar, unsigned x, unsigned& nloc, unsigned& nx) {
  const unsigned G = gridDim.x * gridDim.y * gridDim.z;
  unsigned sum, cnt, mine, sp = 0u;
  for (;;) {
    sum = 0u; cnt = 0u; mine = 0u;
#pragma unroll
    for (unsigned j = 0; j < 16; ++j) { const unsigned c = xb_ld(&bar[XB_XCNT(j)]); sum += c; cnt += (c > 0u) ? 1u : 0u; mine = (j == x) ? c : mine; }
    if (sum == G) break;
    __builtin_amdgcn_s_sleep(1);
    if ((++sp & 255u) == 0u) { if (xb_ld(&bar[XB_TMO])) break; if (sp > XB_SPIN_CAP) { atomicAdd(&bar[XB_TMO], 1u); break; } }
  }
  nloc = mine > 0u ? mine : 1u; nx = cnt > 0u ? cnt : 1u;
}
__device__ __forceinline__ void xcd_barrier(const XcdBarrier& b) {
  asm volatile("s_waitcnt vmcnt(0)" ::: "memory");
  __syncthreads();
  if (threadIdx.x == 0) {
    unsigned* bar = b.bar;
    __builtin_amdgcn_s_waitcnt(0);
    unsigned nloc = b.st[0], nx = b.st[1];
    if (nloc == 0u) { xcd_barrier_complete(bar, b.x, nloc, nx); b.st[0] = nloc; b.st[1] = nx; }
    const unsigned old = xb_add(&bar[XB_XSUB(b.x)], 1u);
    const unsigned gen = old / nloc;
    if (old + 1u == (gen + 1u) * nloc) {
      __builtin_amdgcn_fence(__ATOMIC_RELEASE, "agent");
      asm volatile("s_waitcnt vmcnt(0)" ::: "memory");
      const unsigned og = xb_add(&bar[XB_TOP], 1u);
      const unsigned tg = og / nx;
      if (og + 1u == (tg + 1u) * nx) xb_add(&bar[XB_TOPGEN], 1u);
      else XB_SPIN(xb_ld(&bar[XB_TOPGEN]) == tg, bar);
      __builtin_amdgcn_fence(__ATOMIC_ACQUIRE, "agent");
      xb_add(&bar[XB_XGEN(b.x)], 1u);
      asm volatile("s_waitcnt vmcnt(0)" ::: "memory");
    } else {
      XB_SPIN(xb_ld(&bar[XB_XGEN(b.x)]) == gen, bar);
      __builtin_amdgcn_fence(__ATOMIC_ACQUIRE, "agent");
      asm volatile("s_waitcnt vmcnt(0)" ::: "memory");
    }
  }
  __syncthreads();
}

#define LDT 72
#define LDC 132
__device__ __forceinline__ void gemm_compute64(f32x4 (&acc)[4][4], const u16* sA, const u16* sB, int wr, int wc, int r16, int quad) {
#pragma unroll
  for (int kk = 0; kk < 2; kk++) {
    const int co = ((kk * 4 + quad) ^ (r16 & 7)) * 8;
    bf16x8 a[4], b[4];
#pragma unroll
    for (int i = 0; i < 4; i++) a[i] = ld8(sA + (wr * 64 + i * 16 + r16) * 64 + co);
#pragma unroll
    for (int j = 0; j < 4; j++) b[j] = ld8(sB + (wc * 64 + j * 16 + r16) * 64 + co);
#pragma unroll
    for (int i = 0; i < 4; i++)
#pragma unroll
      for (int j = 0; j < 4; j++) acc[i][j] = MFMA16(a[i], b[j], acc[i][j]);
  }
}
#define GT_LOAD(RA, RB, KOFF) { _Pragma("unroll") for (int i = 0; i < 4; i++) { RA[i] = *(const u32x4*)((A + ((KOFF) + i * 32 * lda)) + va); RB[i] = *(const u32x4*)((B + ((KOFF) + i * 32 * ldb)) + vb); } }
#define GT_STORE(RA, RB, BUF) { u16* _a = smem16 + (BUF) * 16384; _Pragma("unroll") for (int i = 0; i < 4; i++) { *(u32x4*)(_a + (lrow + 32 * i) * 64 + lsw) = RA[i]; *(u32x4*)(_a + 8192 + (lrow + 32 * i) * 64 + lsw) = RB[i]; } }
#define GT_COMPUTE(BUF) gemm_compute64(acc, smem16 + (BUF) * 16384, smem16 + (BUF) * 16384 + 8192, wr, wc, r16, quad)
__device__ __forceinline__ void gemm_tile(f32x4 (&acc)[4][4], const u16* __restrict__ A, int lda, const u16* __restrict__ B, int ldb,
                                          int K, u16* smem16, u16* unused_) {
  const int tid = threadIdx.x, lane = tid & 63, wid = tid >> 6, wr = wid >> 1, wc = wid & 1, r16 = lane & 15, quad = lane >> 4;
  const int lrow = tid >> 3, lkc = (tid & 7) * 8, lsw = ((tid & 7) ^ (lrow & 7)) * 8;
  const unsigned va = lrow * lda + lkc, vb = lrow * ldb + lkc;
  u32x4 ra0[4], rb0[4], ra1[4], rb1[4];
  const int nk = K >> 6;
  GT_LOAD(ra0, rb0, 0);
  GT_LOAD(ra1, rb1, 64);
  __syncthreads();
  GT_STORE(ra0, rb0, 0);
  GT_LOAD(ra0, rb0, 128);
  __syncthreads();
  for (int kt = 0; kt < nk; kt += 2) {
    GT_STORE(ra1, rb1, 1);
    { const int kn = min(kt + 3, nk - 1) * 64; GT_LOAD(ra1, rb1, kn); }
    GT_COMPUTE(0);
    __syncthreads();
    GT_STORE(ra0, rb0, 0);
    { const int kn = min(kt + 4, nk - 1) * 64; GT_LOAD(ra0, rb0, kn); }
    GT_COMPUTE(1);
    __syncthreads();
  }
}
__device__ __forceinline__ void gemm_tile2(f32x4 (&acc)[4][4], const u16* __restrict__ A, int lda, const u16* __restrict__ B, int ldb,
                                           int K, u16* smem16) {
  const int tid = threadIdx.x, lane = tid & 63, wid = tid >> 6, wr = wid >> 1, wc = wid & 1, r16 = lane & 15, quad = lane >> 4;
  const int lrow = tid >> 3, lkc = (tid & 7) * 8, lsw = ((tid & 7) ^ (lrow & 7)) * 8;
  const unsigned va = lrow * lda + lkc, vb = lrow * ldb + lkc;
  u32x4 ra0[4], rb0[4];
  const int nk = K >> 6;
  GT_LOAD(ra0, rb0, 0);
  __syncthreads();
  GT_STORE(ra0, rb0, 0);
  GT_LOAD(ra0, rb0, 64);
  __syncthreads();
  const int co0 = ((0 + quad) ^ (r16 & 7)) * 8, co1 = ((4 + quad) ^ (r16 & 7)) * 8;
#pragma unroll 1
  for (int kt = 0; kt < nk; kt++) {
    const u16* sAc = smem16 + (kt & 1) * 16384; const u16* sBc = sAc + 8192;
    bf16x8 a0[4], b0[4], a1[4], b1[4];
#pragma unroll
    for (int i = 0; i < 4; i++) { a0[i] = ld8(sAc + (wr * 64 + i * 16 + r16) * 64 + co0); a1[i] = ld8(sAc + (wr * 64 + i * 16 + r16) * 64 + co1); }
#pragma unroll
    for (int j = 0; j < 4; j++) { b0[j] = ld8(sBc + (wc * 64 + j * 16 + r16) * 64 + co0); b1[j] = ld8(sBc + (wc * 64 + j * 16 + r16) * 64 + co1); }
    __builtin_amdgcn_sched_barrier(0);
    {
      u16* _a = smem16 + ((kt + 1) & 1) * 16384;
#pragma unroll
      for (int i = 0; i < 4; i++) { *(u32x4*)(_a + (lrow + 32 * i) * 64 + lsw) = ra0[i]; *(u32x4*)(_a + 8192 + (lrow + 32 * i) * 64 + lsw) = rb0[i]; }
    }
    { const int kn = min(kt + 2, nk - 1) * 64; GT_LOAD(ra0, rb0, kn); }
    __builtin_amdgcn_sched_barrier(0);
#pragma unroll
    for (int i = 0; i < 4; i++)
#pragma unroll
      for (int j = 0; j < 4; j++) acc[i][j] = MFMA16(a0[i], b0[j], acc[i][j]);
#pragma unroll
    for (int i = 0; i < 4; i++)
#pragma unroll
      for (int j = 0; j < 4; j++) acc[i][j] = MFMA16(a1[i], b1[j], acc[i][j]);
    __syncthreads();
  }
}
__device__ __forceinline__ void gemm_tile1(f32x4 (&acc)[4][4], const u16* __restrict__ A, int lda, const u16* __restrict__ B, int ldb,
                                           int K, u16* smem16, u16* unused_) {
  const int tid = threadIdx.x, lane = tid & 63, wid = tid >> 6, wr = wid >> 1, wc = wid & 1, r16 = lane & 15, quad = lane >> 4;
  const int lrow = tid >> 3, lkc = (tid & 7) * 8, lsw = ((tid & 7) ^ (lrow & 7)) * 8;
  const unsigned va = lrow * lda + lkc, vb = lrow * ldb + lkc;
  u32x4 ra0[4], rb0[4];
  const int nk = K >> 6;
  GT_LOAD(ra0, rb0, 0);
  __syncthreads();
  GT_STORE(ra0, rb0, 0);
  GT_LOAD(ra0, rb0, 64);
  __syncthreads();
  for (int kt = 0; kt < nk; kt += 2) {
    GT_STORE(ra0, rb0, 1);
    { const int kn = min(kt + 2, nk - 1) * 64; GT_LOAD(ra0, rb0, kn); }
    GT_COMPUTE(0);
    __syncthreads();
    GT_STORE(ra0, rb0, 0);
    { const int kn = min(kt + 3, nk - 1) * 64; GT_LOAD(ra0, rb0, kn); }
    GT_COMPUTE(1);
    __syncthreads();
  }
}
__device__ __forceinline__ void acc_zero(f32x4 (&acc)[4][4]) {
#pragma unroll
  for (int i = 0; i < 4; i++)
#pragma unroll
    for (int j = 0; j < 4; j++) acc[i][j] = (f32x4){0.f, 0.f, 0.f, 0.f};
}
__device__ __forceinline__ void acc_to_lds(const f32x4 (&acc)[4][4], float* sC) {
  const int tid = threadIdx.x, lane = tid & 63, wid = tid >> 6, wr = wid >> 1, wc = wid & 1, r16 = lane & 15, quad = lane >> 4;
  __syncthreads();
#pragma unroll
  for (int i = 0; i < 4; i++)
#pragma unroll
    for (int j = 0; j < 4; j++)
#pragma unroll
      for (int e = 0; e < 4; e++) sC[(wr * 64 + i * 16 + quad * 4 + e) * LDC + wc * 64 + j * 16 + r16] = acc[i][j][e];
  __syncthreads();
}
__device__ __forceinline__ void load_row64(float (&v)[64], const float* sC, int row, int half) {
  const float4* s = (const float4*)(sC + row * LDC + half * 64);
#pragma unroll
  for (int i = 0; i < 16; i++) { float4 t = s[i]; v[4 * i] = t.x; v[4 * i + 1] = t.y; v[4 * i + 2] = t.z; v[4 * i + 3] = t.w; }
}
__device__ __forceinline__ void store64_bf16(u16* dst, const float (&v)[64]) {
#pragma unroll
  for (int i = 0; i < 8; i++) {
    uint4 w = make_uint4(pack2(v[8 * i], v[8 * i + 1]), pack2(v[8 * i + 2], v[8 * i + 3]), pack2(v[8 * i + 4], v[8 * i + 5]), pack2(v[8 * i + 6], v[8 * i + 7]));
    ((uint4*)dst)[i] = w;
  }
}
__device__ __forceinline__ void store64_f32(float* dst, const float (&v)[64]) {
#pragma unroll
  for (int i = 0; i < 16; i++) ((float4*)dst)[i] = make_float4(v[4 * i], v[4 * i + 1], v[4 * i + 2], v[4 * i + 3]);
}

__device__ __forceinline__ bool xcd_tile(int q, int ncol, int& mt, int& nt) {
  const int x = blockIdx.x & 7;
  if (q >= 12 * ncol) return false;
  nt = q / 12; mt = (q % 12) * 8 + x;
  return true;
}
__device__ __forceinline__ void transpose_item(const Params& p, int item, char* smem) {
  char* ws = p.ws; const int tid = threadIdx.x; u16* tt = (u16*)smem;
      const int l = item / 1476, r = item % 1476, grp = r >> 2, kq = r & 3;
      const float* S; int sN, n0, drow0; u16* Dst;
      if (grp < 209) { S = p.w_in + (size_t)l * 1024 * INW; sN = INW; n0 = grp * 32; drow0 = grp < 145 ? n0 : n0 + 96; Dst = (u16*)(ws + OFF_WINT) + (size_t)l * INWP * 1024; }
      else if (grp < 241) { S = p.w_attn_o + (size_t)l * 1048576; sN = 1024; n0 = (grp - 209) * 32; drow0 = n0; Dst = (u16*)(ws + OFF_WAOT) + (size_t)l * 1048576; }
      else if (grp < 273) { S = p.w_gla_o + (size_t)l * 1048576; sN = 1024; n0 = (grp - 241) * 32; drow0 = n0; Dst = (u16*)(ws + OFF_WGOT) + (size_t)l * 1048576; }
      else if (grp < 305) { S = p.w_out + (size_t)l * 1048576; sN = 1024; n0 = (grp - 273) * 32; drow0 = n0; Dst = (u16*)(ws + OFF_WOUT) + (size_t)l * 1048576; }
      else { S = p.peer_wq + (size_t)l * 2097152; sN = 2048; n0 = (grp - 305) * 32; drow0 = n0; Dst = (u16*)(ws + OFF_WQT) + (size_t)l * 2097152; }
      const int k0 = kq * 256;
      const int rr = tid >> 3, c4 = tid & 7;
      __syncthreads();
#pragma unroll
      for (int it = 0; it < 8; it++) {
        const int k = it * 32 + rr;
        const f32x4 v = __builtin_nontemporal_load((const f32x4*)(S + (size_t)(k0 + k) * sN + n0 + c4 * 4));
        tt[(c4 * 4 + 0) * 264 + k] = f2bf(v.x); tt[(c4 * 4 + 1) * 264 + k] = f2bf(v.y);
        tt[(c4 * 4 + 2) * 264 + k] = f2bf(v.z); tt[(c4 * 4 + 3) * 264 + k] = f2bf(v.w);
      }
      __syncthreads();
#pragma unroll
      for (int it = 0; it < 4; it++) {
        const int ch = c4 + 8 * it;
        *(uint4*)(Dst + (size_t)(drow0 + rr) * 1024 + k0 + ch * 8) = *(const uint4*)(tt + rr * 264 + ch * 8);
      }
}
__device__ __forceinline__ void transpose_layer1_idle(const Params& p, char* smem) {
  const int j = blockIdx.x >> 3, x = blockIdx.x & 7, nj = gridDim.x >> 3, jh = nj >> 1, nconv = nj - jh;
  if (j < jh) return;
  const int part = x * nconv + (j - jh), nparts = 8 * nconv;
  __syncthreads();
  for (int item = 1476 + part; item < 2952; item += nparts) transpose_item(p, item, smem);
  __syncthreads();
}
__device__ __forceinline__ void conv_peer_table(const Params& p, int which, int lay) {
  const int j = blockIdx.x >> 3, x = blockIdx.x & 7, nj = gridDim.x >> 3, jh = nj >> 1, nconv = nj - jh;
  if (j < jh) return;
  const int part = x * nconv + (j - jh), nparts = 8 * nconv;
  const float* src = (which == 0 ? p.peer_u : p.peer_v) + (size_t)lay * 16384 * 1024;
  char* dstb = p.ws + (which == 0 ? OFF_U16 : OFF_V16) + (size_t)lay * 16384 * 1024;
  const float sc = which == 0 ? 128.f : 16.f;
  const size_t nch = 16384ull * 1024 / 8, per = (nch + nparts - 1) / nparts;
  const size_t c0 = (size_t)part * per, c1 = c0 + per < nch ? c0 + per : nch;
  for (size_t i = c0 + threadIdx.x; i < c1; i += 256) {
    const f32x4 a = __builtin_nontemporal_load((const f32x4*)src + 2 * i), b = __builtin_nontemporal_load((const f32x4*)src + 2 * i + 1);
    int lo = 0, hi = 0;
    lo = __builtin_amdgcn_cvt_pk_fp8_f32(a.x * sc, a.y * sc, lo, false); lo = __builtin_amdgcn_cvt_pk_fp8_f32(a.z * sc, a.w * sc, lo, true);
    hi = __builtin_amdgcn_cvt_pk_fp8_f32(b.x * sc, b.y * sc, hi, false); hi = __builtin_amdgcn_cvt_pk_fp8_f32(b.z * sc, b.w * sc, hi, true);
    ((int2*)dstb)[i] = make_int2(lo, hi);
  }
}
__device__ __forceinline__ void phase_prep(const Params& p, char* smem) {
  const int tid = threadIdx.x;
  const int G = gridDim.x;
  const size_t gtid = (size_t)blockIdx.x * 256 + tid, gsz = (size_t)G * 256;
  char* ws = p.ws;
  for (int item = blockIdx.x; item < 1476; item += G) transpose_item(p, item, smem);
  __syncthreads();
  for (size_t i = gtid; i < 2ull * 96 * 128; i += gsz) {
    const int l = (int)(i / (96 * 128)); const size_t r = i % (96 * 128);
    ((uint4*)((u16*)(ws + OFF_WINT) + ((size_t)l * INWP + 4640) * 1024))[r] = make_uint4(0, 0, 0, 0);
  }
  {
    for (size_t i = gtid; i < 65536 / 8; i += gsz) {
      const float4 a = ((const float4*)p.peer_sub_keys)[2 * i], b = ((const float4*)p.peer_sub_keys)[2 * i + 1];
      ((uint4*)(ws + OFF_SKB))[i] = make_uint4(pack2(a.x, a.y), pack2(a.z, a.w), pack2(b.x, b.y), pack2(b.z, b.w));
    }
  }
  for (size_t i = gtid; i < 32768; i += gsz) {
    const int pos = (int)(i >> 5), j = (int)(i & 31), a = j >> 4, f = j & 15;
    const float coord = (float)(a == 0 ? (pos >> 6) : (pos & 63));
    const float inv = exp2f(-(float)f * (13.287712379549449f / 16.f));
    const float ang = coord * inv;
    ((float*)(ws + OFF_ROPE))[i] = cosf(ang);
    ((float*)(ws + OFF_ROPE))[32768 + i] = sinf(ang);
  }
  for (size_t i = gtid; i < 4ull * 2 * 512 * 256; i += gsz) {
    const int d = (int)(i & 63), kvh = (int)((i >> 6) & 3), j = (int)((i >> 8) & 511), l = (int)((i >> 17) & 1), b = (int)(i >> 18);
    ((u16*)(ws + OFF_KL))[(((size_t)l * 4 + b) * LKEYS + 1024 + j) * 256 + kvh * 64 + d] = f2bf(p.cache_k[i]);
    ((u16*)(ws + OFF_VTL))[((((size_t)l * 4 + b) * 4 + kvh) * 64 + d) * LKEYS + 1024 + j] = f2bf(p.cache_v[i]);
  }
  {
    float* sc = (float*)smem;
    float* red = (float*)(smem + 20480);
    for (int item = blockIdx.x; item < 384; item += G) {
      const int l = item / 192, n0 = (item % 192) * 32;
      __syncthreads();
      for (int i = tid; i < 5120; i += 256) {
        const int g = i >> 10, k = i & 1023;
        const float cv = g == 0 ? p.c_ctx[k] : p.c[(g - 1) * 1024 + k];
        sc[i] = siluf_(cv);
      }
      __syncthreads();
      const int c = tid & 31, kg = tid >> 5;
      float a0 = 0, a1 = 0, a2 = 0, a3 = 0, a4 = 0;
      const float* w = p.ada_w + ((size_t)l * 1024 + kg * 128) * 6144 + n0 + c;
      const float* s0 = sc + kg * 128;
#pragma unroll 8
      for (int k = 0; k < 128; k++) {
        const float wv = __builtin_nontemporal_load(w + (size_t)k * 6144);
        a0 += s0[k] * wv; a1 += s0[1024 + k] * wv; a2 += s0[2048 + k] * wv; a3 += s0[3072 + k] * wv; a4 += s0[4096 + k] * wv;
      }
      red[(kg * 5 + 0) * 32 + c] = a0; red[(kg * 5 + 1) * 32 + c] = a1; red[(kg * 5 + 2) * 32 + c] = a2;
      red[(kg * 5 + 3) * 32 + c] = a3; red[(kg * 5 + 4) * 32 + c] = a4;
      __syncthreads();
      if (tid < 160) {
        const int g = tid >> 5, cc = tid & 31;
        float s = 0;
#pragma unroll
        for (int q = 0; q < 8; q++) s += red[(q * 5 + g) * 32 + cc];
        ((float*)(ws + OFF_MOD))[((size_t)l * 5 + g) * 6144 + n0 + cc] = s + p.ada_b[(size_t)l * 6144 + n0 + cc];
      }
    }
    __syncthreads();
  }
}

__device__ __forceinline__ void phase_xin(const Params& p) {
  const size_t gtid = (size_t)blockIdx.x * 256 + threadIdx.x, gsz = (size_t)gridDim.x * 256;
  const float* mod = (const float*)(p.ws + OFF_MOD);
  for (size_t i = gtid; i < (size_t)NTOK * 256; i += gsz) {
    const int token = (int)(i >> 8), c = (int)(i & 255) * 4;
    const f32x4 xv = token < NCTX ? __builtin_nontemporal_load((const f32x4*)p.x_prompt + i) : __builtin_nontemporal_load((const f32x4*)p.x_sample + (i - (size_t)NCTX * 256));
    const float4 x = make_float4(xv.x, xv.y, xv.z, xv.w);
    ((float4*)(p.ws + OFF_X))[i] = x;
    const float* m = mod + (size_t)tok_group(token) * 6144;
    const float4 sh = *(const float4*)(m + c), sc = *(const float4*)(m + 1024 + c);
    uint2 w = make_uint2(pack2(x.x * (1.f + sc.x) + sh.x, x.y * (1.f + sc.y) + sh.y), pack2(x.z * (1.f + sc.z) + sh.z, x.w * (1.f + sc.w) + sh.w));
    ((uint2*)(p.ws + OFF_H))[i] = w;
  }
}

__device__ __forceinline__ void phase_gemm1(const Params& p, int l, char* smem) {
  char* ws = p.ws;
  u16* sA = (u16*)smem; u16* sB = sA + 128 * LDT; float* sC = (float*)smem;
  const int tid = threadIdx.x;
  const u16* H = (const u16*)(ws + OFF_H);
  const u16* W = (const u16*)(ws + OFF_WINT) + (size_t)l * INWP * 1024;
  const float* ropeC = (const float*)(ws + OFF_ROPE); const float* ropeS = ropeC + 32768;
  for (int q = blockIdx.x >> 3; ; q += gridDim.x >> 3) {
    int mt, nt; if (!xcd_tile(q, 53, mt, nt)) break;
    const int t0 = mt * 128;
    f32x4 acc[4][4]; acc_zero(acc);
    gemm_tile2(acc, H + (size_t)t0 * 1024, 1024, W + (size_t)nt * 128 * 1024, 1024, 1024, sA);
    acc_to_lds(acc, sC);
    const int row = tid >> 1, half = tid & 1, token = t0 + row;
    const bool lat = t0 >= NCTX;
    const int bb = lat ? (t0 - NCTX) >> 10 : t0 >> 8;
    const int pos = lat ? (token - NCTX) & 1023 : token & 255;
    const int pos0 = lat ? (t0 - NCTX) & 1023 : t0 & 255;
    if (nt < 10) {
      float v[64]; load_row64(v, sC, row, half);
      float ss = 0;
#pragma unroll
      for (int c = 0; c < 64; c++) ss += v[c] * v[c];
      const float r = rsqrtf(ss * (1.f / 64.f) + 1e-6f) * (nt < 8 ? 0.125f : 1.f);
      const float* nw = (nt < 8 ? p.q_norm : p.k_norm) + l * 64;
#pragma unroll
      for (int c = 0; c < 64; c++) v[c] = v[c] * r * nw[c];
      if (lat) {
        const float* cp = ropeC + pos * 32; const float* sp = ropeS + pos * 32;
#pragma unroll
        for (int a = 0; a < 2; a++)
#pragma unroll
          for (int f = 0; f < 16; f++) {
            const float cs = cp[a * 16 + f], sn = sp[a * 16 + f];
            const float x1 = v[a * 32 + f], x2 = v[a * 32 + 16 + f];
            v[a * 32 + f] = x1 * cs - x2 * sn; v[a * 32 + 16 + f] = x2 * cs + x1 * sn;
          }
      }
      {
        float4* d = (float4*)(sC + row * LDC + half * 64);
#pragma unroll
        for (int i = 0; i < 16; i++) d[i] = make_float4(v[4 * i], v[4 * i + 1], v[4 * i + 2], v[4 * i + 3]);
      }
      __syncthreads();
      u16* dst; size_t rstride;
      if (nt < 8) { dst = (u16*)(ws + OFF_Q) + (size_t)t0 * 1024 + nt * 128; rstride = 1024; }
      else if (!lat) { dst = (u16*)(ws + OFF_KC) + (size_t)t0 * 256 + (nt - 8) * 128; rstride = 256; }
      else { dst = (u16*)(ws + OFF_KL) + (((size_t)l * 4 + bb) * LKEYS + pos0) * 256 + (nt - 8) * 128; rstride = 256; }
#pragma unroll 2
      for (int i = 0; i < 8; i++) {
        const int id = i * 256 + tid, rr = id >> 4, c8 = (id & 15) * 8;
        const float4 a = *(const float4*)(sC + rr * LDC + c8), b2 = *(const float4*)(sC + rr * LDC + c8 + 4);
        *(uint4*)(dst + (size_t)rr * rstride + c8) = make_uint4(pack2(a.x, a.y), pack2(a.z, a.w), pack2(b2.x, b2.y), pack2(b2.z, b2.w));
      }
      if (nt >= 8 && !lat) {
        float* ok = p.out + OUT_K + (((size_t)bb * 2 + l) * 256 + pos0) * 256 + (nt - 8) * 128;
#pragma unroll 4
        for (int i = 0; i < 16; i++) {
          const int id = i * 256 + tid, rr = id >> 5, c4 = (id & 31) * 4;
          *(float4*)(ok + (size_t)rr * 256 + c4) = *(const float4*)(sC + rr * LDC + c4);
        }
      }
    } else if (nt < 12) {
      if (!lat) {
        float* ov = p.out + OUT_V + (((size_t)bb * 2 + l) * 256 + pos0) * 256 + (nt - 10) * 128;
#pragma unroll 4
        for (int i = 0; i < 16; i++) {
          const int id = i * 256 + tid, rr = id >> 5, c4 = (id & 31) * 4;
          *(float4*)(ov + (size_t)rr * 256 + c4) = *(const float4*)(sC + rr * LDC + c4);
        }
      }
#pragma unroll 2
      for (int i = 0; i < 8; i++) {
        const int id = i * 256 + tid, col = id >> 4, tc = id & 15, kvh = (nt - 10) * 2 + (col >> 6), d = col & 63;
        const float* sp = sC + (tc * 8) * LDC + col;
        u16* dst = lat ? (u16*)(ws + OFF_VTL) + ((((size_t)l * 4 + bb) * 4 + kvh) * 64 + d) * LKEYS + pos0 + tc * 8
                       : (u16*)(ws + OFF_VTC) + (((size_t)bb * 4 + kvh) * 64 + d) * 256 + pos0 + tc * 8;
        *(uint4*)dst = make_uint4(pack2(sp[0], sp[LDC]), pack2(sp[2 * LDC], sp[3 * LDC]), pack2(sp[4 * LDC], sp[5 * LDC]), pack2(sp[6 * LDC], sp[7 * LDC]));
      }
    } else if (nt == 36) {
      if (half == 0) {
        const float4* s4 = (const float4*)(sC + row * LDC);
        float4* dst = (float4*)((float*)(ws + OFF_GLR) + (size_t)token * 32);
#pragma unroll
        for (int i = 0; i < 8; i++) dst[i] = s4[i];
      }
    } else if (nt >= 20 && nt < 28) {
#pragma unroll 2
      for (int i = 0; i < 8; i++) {
        const int id = i * 256 + tid, th = id >> 10, col = (id >> 3) & 127, tc = id & 7;
        const float* sp = sC + (th * 64 + tc * 8) * LDC + col;
        *(uint4*)((u16*)(ws + OFF_GV) + ((size_t)((t0 >> 6) + th) * 1024 + (nt - 20) * 128 + col) * 64 + tc * 8) =
            make_uint4(pack2(sp[0], sp[LDC]), pack2(sp[2 * LDC], sp[3 * LDC]), pack2(sp[4 * LDC], sp[5 * LDC]), pack2(sp[6 * LDC], sp[7 * LDC]));
      }
    } else {
      u16* dst; size_t rstride; int mode;
      if (nt < 16) { dst = (u16*)(ws + OFF_GQ) + (size_t)t0 * 512 + (nt - 12) * 128; rstride = 512; mode = 1; }
      else if (nt < 20) { dst = (u16*)(ws + OFF_GK) + (size_t)t0 * 512 + (nt - 16) * 128; rstride = 512; mode = 0; }
      else if (nt < 36) { dst = (u16*)(ws + OFF_GOUT) + (size_t)t0 * 1024 + (nt - 28) * 128; rstride = 1024; mode = 0; }
      else { dst = (u16*)(ws + OFF_GM) + (size_t)t0 * 2048 + (nt - 37) * 128; rstride = 2048; mode = 2; }
#pragma unroll 2
      for (int i = 0; i < 8; i++) {
        const int id = i * 256 + tid, rr = id >> 4, c8 = (id & 15) * 8;
        float4 a = *(const float4*)(sC + rr * LDC + c8), b2 = *(const float4*)(sC + rr * LDC + c8 + 4);
        if (mode == 1) { a.x *= 0.08838834764831845f; a.y *= 0.08838834764831845f; a.z *= 0.08838834764831845f; a.w *= 0.08838834764831845f;
                         b2.x *= 0.08838834764831845f; b2.y *= 0.08838834764831845f; b2.z *= 0.08838834764831845f; b2.w *= 0.08838834764831845f; }
        if (mode == 2) { a.x = sigmoidf_(a.x); a.y = sigmoidf_(a.y); a.z = sigmoidf_(a.z); a.w = sigmoidf_(a.w);
                         b2.x = sigmoidf_(b2.x); b2.y = sigmoidf_(b2.y); b2.z = sigmoidf_(b2.z); b2.w = sigmoidf_(b2.w); }
        *(uint4*)(dst + (size_t)rr * rstride + c8) = make_uint4(pack2(a.x, a.y), pack2(a.z, a.w), pack2(b2.x, b2.y), pack2(b2.z, b2.w));
      }
    }
  }
}

__device__ __forceinline__ void attn_item(const Params& p, int l, int item, char* smem) {
  char* ws = p.ws;
  const int tid = threadIdx.x, lane = tid & 63, w = tid >> 6, r16 = lane & 15, quad = lane >> 4;
  int tok0, h, qb, nkeys, vstride; const u16* kptr; const u16* vptr;
  if (item < 512) {
    const int b = item >> 7; h = (item >> 3) & 15; qb = item & 7; tok0 = NCTX + b * 1024; nkeys = LKEYS; vstride = LKEYS;
    kptr = (const u16*)(ws + OFF_KL) + ((size_t)l * 4 + b) * LKEYS * 256 + (h >> 2) * 64;
    vptr = (const u16*)(ws + OFF_VTL) + (((size_t)l * 4 + b) * 4 + (h >> 2)) * 64 * LKEYS;
  } else {
    const int it = item - 512; const int b = it >> 5; h = (it >> 1) & 15; qb = it & 1; tok0 = b * 256; nkeys = 256; vstride = 256;
    kptr = (const u16*)(ws + OFF_KC) + (size_t)b * 256 * 256 + (h >> 2) * 64;
    vptr = (const u16*)(ws + OFF_VTC) + ((size_t)b * 4 + (h >> 2)) * 64 * 256;
  }
  const int qrow0 = tok0 + qb * 128 + w * 32;
  const u16* qptr = (const u16*)(ws + OFF_Q) + (size_t)qrow0 * 1024 + h * 64;
  bf16x8 qf[2][2];
#pragma unroll
  for (int qt = 0; qt < 2; qt++)
#pragma unroll
    for (int dh = 0; dh < 2; dh++) qf[qt][dh] = ld8(qptr + (size_t)(qt * 16 + r16) * 1024 + dh * 32 + quad * 8);
  f32x4 o[4][2];
#pragma unroll
  for (int dt = 0; dt < 4; dt++) { o[dt][0] = (f32x4){0, 0, 0, 0}; o[dt][1] = (f32x4){0, 0, 0, 0}; }
  float mrow[2] = {-1e30f, -1e30f}, lrow[2] = {0.f, 0.f};
  const int lr = tid >> 3, lc = (tid & 7) * 8;
  u32x4 rk[2], rv[2];
  const int nkb = nkeys >> 6;
#define AT_LOAD(KB) { _Pragma("unroll") for (int i = 0; i < 2; i++) { \
      rk[i] = *(const u32x4*)(kptr + (size_t)((KB) * 64 + lr + 32 * i) * 256 + lc); \
      rv[i] = *(const u32x4*)(vptr + (size_t)(lr + 32 * i) * vstride + (KB) * 64 + lc); } }
#define AT_STORE(BUF) { u16* _k = sK0 + (BUF) * (128 * LDT); _Pragma("unroll") for (int i = 0; i < 2; i++) { *(u32x4*)(_k + (lr + 32 * i) * LDT + lc) = rk[i]; *(u32x4*)(_k + 64 * LDT + (lr + 32 * i) * LDT + lc) = rv[i]; } }
  u16* const sK0 = (u16*)smem;
  AT_LOAD(0);
  __syncthreads();
  AT_STORE(0);
  AT_LOAD(1);
  __syncthreads();
  for (int kb = 0; kb < nkb; kb++) {
    AT_STORE((kb + 1) & 1);
    { const int kn = min(kb + 2, nkb - 1); AT_LOAD(kn); }
    const u16* sK = sK0 + (kb & 1) * (128 * LDT);
    const u16* sV = sK + 64 * LDT;
    f32x4 st[4][2];
#pragma unroll
    for (int kt = 0; kt < 4; kt++) {
      const bf16x8 k0 = ld8(sK + (kt * 16 + r16) * LDT + quad * 8), k1 = ld8(sK + (kt * 16 + r16) * LDT + 32 + quad * 8);
#pragma unroll
      for (int qt = 0; qt < 2; qt++) {
        f32x4 z = (f32x4){0, 0, 0, 0};
        z = MFMA16(k0, qf[qt][0], z);
        z = MFMA16(k1, qf[qt][1], z);
        st[kt][qt] = z;
      }
    }
    bf16x8 pb[2][2];
#pragma unroll
    for (int qt = 0; qt < 2; qt++) {
      float mx = -1e30f;
#pragma unroll
      for (int kt = 0; kt < 4; kt++)
#pragma unroll
        for (int e = 0; e < 4; e++) { st[kt][qt][e] *= 1.4426950408889634f; mx = fmaxf(mx, st[kt][qt][e]); }
      mx = fmaxf(mx, __shfl_xor(mx, 16)); mx = fmaxf(mx, __shfl_xor(mx, 32));
      const float mn = fmaxf(mrow[qt], mx);
      const float alpha = __builtin_amdgcn_exp2f(mrow[qt] - mn);
      mrow[qt] = mn;
      float rs = 0;
#pragma unroll
      for (int kt = 0; kt < 4; kt++)
#pragma unroll
        for (int e = 0; e < 4; e++) { const float pv = __builtin_amdgcn_exp2f(st[kt][qt][e] - mn); st[kt][qt][e] = pv; rs += pv; }
      lrow[qt] = lrow[qt] * alpha + rs;
#pragma unroll
      for (int dt = 0; dt < 4; dt++) o[dt][qt] *= alpha;
#pragma unroll
      for (int kh = 0; kh < 2; kh++) {
        uint4 u = make_uint4(pack2(st[2 * kh][qt][0], st[2 * kh][qt][1]), pack2(st[2 * kh][qt][2], st[2 * kh][qt][3]),
                             pack2(st[2 * kh + 1][qt][0], st[2 * kh + 1][qt][1]), pack2(st[2 * kh + 1][qt][2], st[2 * kh + 1][qt][3]));
        pb[qt][kh] = __builtin_bit_cast(bf16x8, u);
      }
    }
#pragma unroll
    for (int dt = 0; dt < 4; dt++)
#pragma unroll
      for (int kh = 0; kh < 2; kh++) {
        const u16* vp = sV + (dt * 16 + r16) * LDT + kh * 32 + quad * 4;
        const bf16x8 vf = mk8(*(const uint2*)vp, *(const uint2*)(vp + 16));
        o[dt][0] = MFMA16(vf, pb[0][kh], o[dt][0]);
        o[dt][1] = MFMA16(vf, pb[1][kh], o[dt][1]);
      }
    __syncthreads();
  }
#undef AT_LOAD
#undef AT_STORE
  u16* att = (u16*)(ws + OFF_ATT);
#pragma unroll
  for (int qt = 0; qt < 2; qt++) {
    float lt = lrow[qt];
    lt += __shfl_xor(lt, 16); lt += __shfl_xor(lt, 32);
    const float inv = 1.f / lt;
#pragma unroll
    for (int dt = 0; dt < 4; dt++) {
      uint2 u = make_uint2(pack2(o[dt][qt][0] * inv, o[dt][qt][1] * inv), pack2(o[dt][qt][2] * inv, o[dt][qt][3] * inv));
      *(uint2*)(att + (size_t)(qrow0 + qt * 16 + r16) * 1024 + h * 64 + dt * 16 + quad * 4) = u;
    }
  }
}

#define LDQ 136
__device__ __forceinline__ void gla_prep_item(const Params& p, int l, int item, char* smem) {
  char* ws = p.ws;
  u16* sQE = (u16*)smem;
  u16* sKE = sQE + 64 * LDQ;
  u16* sKT = sKE + 64 * LDQ;
  float* sGLR = (float*)(sKT + 128 * LDT);
  float* sTot = sGLR + 1024;
  const int tid = threadIdx.x, lane = tid & 63, w = tid >> 6, r16 = lane & 15, quad = lane >> 4;
  const int c = item >> 3, h = (item >> 1) & 3, dir = item & 1;
  const int tb = c * 64;
  const u16* GQ = (const u16*)(ws + OFF_GQ); const u16* GK = (const u16*)(ws + OFF_GK);
  const float* GLR = (const float*)(ws + OFF_GLR);
  {
    const int tk = tid >> 2, r4 = (tid & 3) * 4;
    *(float4*)(sGLR + tk * 16 + r4) = *(const float4*)(GLR + (size_t)(tb + tk) * 32 + dir * 16 + r4);
#pragma unroll
    for (int i = 0; i < 4; i++) {
      const int ch = tid + 256 * i, rr = ch >> 4, cc = (ch & 15) * 8;
      *(uint4*)(sQE + rr * LDQ + cc) = *(const uint4*)(GQ + (size_t)(tb + rr) * 512 + h * 128 + cc);
      *(uint4*)(sKE + rr * LDQ + cc) = *(const uint4*)(GK + (size_t)(tb + rr) * 512 + h * 128 + cc);
    }
  }
  __syncthreads();
#pragma unroll 1
  for (int dh = 0; dh < 2; dh++) {
    const int dk = dh * 64 + lane, qtr = w;
    float la[16];
    float tot = 0;
    {
      float w2r[16];
#pragma unroll
      for (int r = 0; r < 16; r++) w2r[r] = p.gate_w2[(((size_t)l * 2 + dir) * 16 + r) * 512 + h * 128 + dk];
      const float gb = p.gate_b[((size_t)l * 2 + dir) * 512 + h * 128 + dk];
#pragma unroll
      for (int tt = 0; tt < 16; tt++) {
        const float* g = sGLR + (qtr * 16 + tt) * 16;
        float z = gb;
#pragma unroll
        for (int r = 0; r < 16; r++) z += g[r] * w2r[r];
        const float ls = fminf(z, 0.f) - __logf(1.f + __expf(-fabsf(z)));
        la[tt] = ls * (1.f / 16.f);
        tot += la[tt];
      }
    }
    sTot[qtr * 128 + dk] = tot;
    __syncthreads();
    const float q0 = sTot[dk], q1 = sTot[128 + dk], q2 = sTot[256 + dk], q3 = sTot[384 + dk];
    const float bl = (q0 + q1) + (q2 + q3);
    float run;
    if (dir == 0) {
      run = qtr == 0 ? 0.f : qtr == 1 ? q0 : qtr == 2 ? q0 + q1 : q0 + q1 + q2;
#pragma unroll
      for (int tt = 0; tt < 16; tt++) { run += la[tt]; la[tt] = run; }
    } else {
      run = qtr == 3 ? 0.f : qtr == 2 ? q3 : qtr == 1 ? q3 + q2 : q3 + q2 + q1;
#pragma unroll
      for (int tt = 15; tt >= 0; tt--) { run += la[tt]; la[tt] = run; }
    }
    if (qtr == 0) ((float*)(ws + OFF_EBL))[(size_t)item * 128 + dk] = __expf(bl);
#pragma unroll
    for (int tt = 0; tt < 16; tt++) {
      const int tk = qtr * 16 + tt;
      const float q = bf2f(sQE[tk * LDQ + dk]);
      const float k = bf2f(sKE[tk * LDQ + dk]);
      const float bb = la[tt];
      sQE[tk * LDQ + dk] = f2bf(q * __expf(bb));
      sKE[tk * LDQ + dk] = f2bf(k * __expf(-bb));
      sKT[dk * LDT + tk] = f2bf(k * __expf(bl - bb));
    }
  }
  __syncthreads();
  {
    bf16x8 qb4[4];
#pragma unroll
    for (int ks = 0; ks < 4; ks++) qb4[ks] = ld8(sQE + (w * 16 + r16) * LDQ + ks * 32 + quad * 8);
    u16* PM = (u16*)(ws + OFF_PM) + (size_t)item * 4096;
    const int i = w * 16 + r16;
#pragma unroll
    for (int jt = 0; jt < 4; jt++) {
      f32x4 z = (f32x4){0, 0, 0, 0};
#pragma unroll
      for (int ks = 0; ks < 4; ks++) z = MFMA16(ld8(sKE + (jt * 16 + r16) * LDQ + ks * 32 + quad * 8), qb4[ks], z);
#pragma unroll
      for (int e = 0; e < 4; e++) {
        const int j = jt * 16 + quad * 4 + e;
        const bool keep = dir == 0 ? (j <= i) : (j >= i);
        z[e] = keep ? z[e] : 0.f;
      }
      *(uint2*)(PM + i * 64 + jt * 16 + quad * 4) = make_uint2(pack2(z[0], z[1]), pack2(z[2], z[3]));
    }
  }
  {
    u16* QE = (u16*)(ws + OFF_QE) + (size_t)item * 8192;
    u16* KT = (u16*)(ws + OFF_KT) + (size_t)item * 8192;
#pragma unroll
    for (int i = 0; i < 4; i++) {
      const int ch = tid + 256 * i;
      { const int rr = ch >> 4, cc = (ch & 15) * 8; *(uint4*)(QE + rr * 128 + cc) = *(const uint4*)(sQE + rr * LDQ + cc); }
      { const int rr = ch >> 3, cc = (ch & 7) * 8; *(uint4*)(KT + rr * 64 + cc) = *(const uint4*)(sKT + rr * LDT + cc); }
    }
  }
}

__device__ __forceinline__ void gla_scan_item(const Params& p, int l, int item, char* smem) {
  char* ws = p.ws;
  u16* sST = (u16*)smem;
  const int tid = threadIdx.x, lane = tid & 63, w = tid >> 6, r16 = lane & 15, quad = lane >> 4;
  int b, h, dir, dvs, tok0, nch, grp; bool lat;
  if (item < 512) { lat = true; grp = 3 - (item >> 7); const int it = item & 127; b = it >> 5; h = (it >> 3) & 3; dir = (it >> 2) & 1; dvs = it & 3; tok0 = NCTX + b * 1024; nch = 16; }
  else { const int it = item - 512; lat = false; grp = 0; b = it >> 5; h = (it >> 3) & 3; dir = (it >> 2) & 1; dvs = it & 3; tok0 = b * 256; nch = 4; }
  f32x4 ST[8];
  const size_t sbase = ((((size_t)b * 2 + l) * 2 + dir) * 4 + h) * 128;
  if (lat) {
#pragma unroll
    for (int t = 0; t < 8; t++) {
      const float4 v = *(const float4*)(p.state_gla + (sbase + t * 16 + r16) * 256 + dvs * 64 + w * 16 + quad * 4);
      ST[t] = (f32x4){v.x, v.y, v.z, v.w};
    }
  } else {
#pragma unroll
    for (int t = 0; t < 8; t++) ST[t] = (f32x4){0, 0, 0, 0};
  }
  u16* OUTP = (u16*)(ws + (dir == 0 ? OFF_OF : OFF_OB));
  u16* sKT = sST + 64 * LDQ;
  u16* sGV = sKT + 128 * LDT;
  const int lr = tid >> 3, lc = (tid & 7) * 8;
  u32x4 rkt[4], rgv[2];
#define SC_LOAD(CI) { const int c_ = dir == 0 ? (CI) : nch - 1 - (CI); const int cgl = (tok0 >> 6) + c_; \
    const u16* KT_ = (const u16*)(ws + OFF_KT) + (((size_t)cgl * 4 + h) * 2 + dir) * 8192; \
    const u16* GV_ = (const u16*)(ws + OFF_GV) + ((size_t)cgl * 1024 + h * 256 + dvs * 64) * 64; \
    _Pragma("unroll") for (int i = 0; i < 4; i++) rkt[i] = *(const u32x4*)(KT_ + (lr + 32 * i) * 64 + lc); \
    _Pragma("unroll") for (int i = 0; i < 2; i++) rgv[i] = *(const u32x4*)(GV_ + (lr + 32 * i) * 64 + lc); }
  const int nsteps = grp * 4 + 4;
  SC_LOAD(0);
#pragma unroll 1
  for (int ci = 0; ci < nsteps; ci++) {
    const bool full = ci >= grp * 4;
    const int c = dir == 0 ? ci : nch - 1 - ci;
    const int cg_ = (tok0 >> 6) + c;
    const int tb = cg_ * 64;
    const size_t ip = ((size_t)cg_ * 4 + h) * 2 + dir;
    bf16x8 qb4[4], pbf[2];
    if (full) {
      const u16* QE = (const u16*)(ws + OFF_QE) + ip * 8192;
      const u16* PM = (const u16*)(ws + OFF_PM) + ip * 4096;
#pragma unroll
      for (int ks = 0; ks < 4; ks++) qb4[ks] = ld8(QE + (w * 16 + r16) * 128 + ks * 32 + quad * 8);
#pragma unroll
      for (int kh = 0; kh < 2; kh++) pbf[kh] = ld8(PM + (w * 16 + r16) * 64 + kh * 32 + quad * 8);
    }
    const float* EBL = (const float*)(ws + OFF_EBL) + ip * 128;
    float ebl[8];
#pragma unroll
    for (int t = 0; t < 8; t++) ebl[t] = EBL[t * 16 + r16];
    __syncthreads();
#pragma unroll
    for (int i = 0; i < 4; i++) *(u32x4*)(sKT + (lr + 32 * i) * LDT + lc) = rkt[i];
#pragma unroll
    for (int i = 0; i < 2; i++) *(u32x4*)(sGV + (lr + 32 * i) * LDT + lc) = rgv[i];
    if (full) {
#pragma unroll
      for (int t = 0; t < 8; t++)
#pragma unroll
        for (int e = 0; e < 4; e++) sST[(w * 16 + quad * 4 + e) * LDQ + t * 16 + r16] = f2bf(ST[t][e]);
    }
    __syncthreads();
    { const int cn = min(ci + 1, nsteps - 1); SC_LOAD(cn); }
    const bf16x8 vts0 = ld8(sGV + (w * 16 + r16) * LDT + quad * 8), vts1 = ld8(sGV + (w * 16 + r16) * LDT + 32 + quad * 8);
    if (full) {
#pragma unroll
      for (int dt = 0; dt < 4; dt++) {
        f32x4 oacc = (f32x4){0, 0, 0, 0};
#pragma unroll
        for (int kh = 0; kh < 2; kh++) oacc = MFMA16(ld8(sGV + (dt * 16 + r16) * LDT + kh * 32 + quad * 8), pbf[kh], oacc);
#pragma unroll
        for (int ks = 0; ks < 4; ks++) oacc = MFMA16(ld8(sST + (dt * 16 + r16) * LDQ + ks * 32 + quad * 8), qb4[ks], oacc);
        *(uint2*)(OUTP + (size_t)(tb + w * 16 + r16) * 1024 + h * 256 + dvs * 64 + dt * 16 + quad * 4) = make_uint2(pack2(oacc[0], oacc[1]), pack2(oacc[2], oacc[3]));
      }
    }
#pragma unroll
    for (int t = 0; t < 8; t++) {
      f32x4 z = ST[t] * ebl[t];
      z = MFMA16(vts0, ld8(sKT + (t * 16 + r16) * LDT + quad * 8), z);
      z = MFMA16(vts1, ld8(sKT + (t * 16 + r16) * LDT + 32 + quad * 8), z);
      ST[t] = z;
    }
  }
#undef SC_LOAD
  __syncthreads();
  if (!lat) {
#pragma unroll
    for (int t = 0; t < 8; t++)
      *(float4*)(p.out + OUT_S + (sbase + t * 16 + r16) * 256 + dvs * 64 + w * 16 + quad * 4) = make_float4(ST[t][0], ST[t][1], ST[t][2], ST[t][3]);
  }
}

__device__ __forceinline__ void phase_mixa(const Params& p, int l, char* smem) {
  for (int it = blockIdx.x; it < 512 + 1536; it += gridDim.x) {
    if (it < 512) attn_item(p, l, it, smem); else gla_prep_item(p, l, it - 512, smem);
    __syncthreads();
  }
}
__device__ __forceinline__ void phase_mixb(const Params& p, int l, char* smem) {
  unsigned* ctr = (unsigned*)(p.ws + OFF_BAR) + 3600 + 64 * l;
  __shared__ int s_next;
  int it = blockIdx.x;
  for (;;) {
    if (it >= 1536 + 1024) break;
    if (it < 1536) gla_scan_item(p, l, it, smem); else attn_item(p, l, it - 1536 + 512, smem);
    __syncthreads();
    if (threadIdx.x == 0) s_next = (int)gridDim.x + (int)atomicAdd(ctr, 1u);
    __syncthreads();
    it = s_next;
  }
}

__device__ __forceinline__ void phase_glapost(const Params& p, int l) {
  char* ws = p.ws;
  const int lane = threadIdx.x & 63;
  const int wv = blockIdx.x * 4 + (threadIdx.x >> 6), nw = gridDim.x * 4;
  for (int token = wv; token < NTOK; token += nw) {
    const size_t base = (size_t)token * 1024 + lane * 16;
    const uint4 f0 = *(const uint4*)((u16*)(ws + OFF_OF) + base), f1 = *(const uint4*)((u16*)(ws + OFF_OF) + base + 8);
    const uint4 b0 = *(const uint4*)((u16*)(ws + OFF_OB) + base), b1 = *(const uint4*)((u16*)(ws + OFF_OB) + base + 8);
    const uint4 g0 = *(const uint4*)((u16*)(ws + OFF_GOUT) + base), g1 = *(const uint4*)((u16*)(ws + OFF_GOUT) + base + 8);
    const unsigned fu[8] = {f0.x, f0.y, f0.z, f0.w, f1.x, f1.y, f1.z, f1.w};
    const unsigned bu[8] = {b0.x, b0.y, b0.z, b0.w, b1.x, b1.y, b1.z, b1.w};
    const unsigned gu[8] = {g0.x, g0.y, g0.z, g0.w, g1.x, g1.y, g1.z, g1.w};
    float o[16]; float ss = 0;
#pragma unroll
    for (int i = 0; i < 8; i++) {
      o[2 * i] = bf_lo(fu[i]) + bf_lo(bu[i]); o[2 * i + 1] = bf_hi(fu[i]) + bf_hi(bu[i]);
      ss += o[2 * i] * o[2 * i] + o[2 * i + 1] * o[2 * i + 1];
    }
    ss += __shfl_xor(ss, 1); ss += __shfl_xor(ss, 2); ss += __shfl_xor(ss, 4); ss += __shfl_xor(ss, 8);
    const float r = rsqrtf(ss * (1.f / 256.f) + 1e-6f);
    const float* gn = p.gla_norm + l * 256 + (lane & 15) * 16;
    unsigned ou[8];
#pragma unroll
    for (int i = 0; i < 8; i++) {
      const float a = o[2 * i] * r * gn[2 * i] * siluf_(bf_lo(gu[i]));
      const float b = o[2 * i + 1] * r * gn[2 * i + 1] * siluf_(bf_hi(gu[i]));
      ou[i] = pack2(a, b);
    }
    *(uint4*)((u16*)(ws + OFF_OF) + base) = make_uint4(ou[0], ou[1], ou[2], ou[3]);
    *(uint4*)((u16*)(ws + OFF_OF) + base + 8) = make_uint4(ou[4], ou[5], ou[6], ou[7]);
  }
}

__device__ __forceinline__ void phase_gemm_ao(const Params& p, int l, char* smem) {
  char* ws = p.ws;
  u16* sA = (u16*)smem; u16* sB = sA + 128 * LDT; float* sC = (float*)smem;
  const int tid = threadIdx.x, lane = tid & 63, wid = tid >> 6, wr = wid >> 1, wc = wid & 1, r16 = lane & 15, quad = lane >> 4;
  const u16* GM = (const u16*)(ws + OFF_GM);
  for (int q = blockIdx.x >> 3; ; q += gridDim.x >> 3) {
    int mt, nt; if (!xcd_tile(q, 8, mt, nt)) break;
    const int t0 = mt * 128, n0 = nt * 128;
    f32x4 acc[4][4]; acc_zero(acc);
    gemm_tile2(acc, (const u16*)(ws + OFF_ATT) + (size_t)t0 * 1024, 1024, (const u16*)(ws + OFF_WAOT) + ((size_t)l * 1024 + n0) * 1024, 1024, 1024, sA);
    acc_to_lds(acc, sC);
#pragma unroll 2
    for (int i = 0; i < 8; i++) {
      const int id = i * 256 + tid, row = id >> 4, c8 = (id & 15) * 8;
      const u16* gp = GM + (size_t)(t0 + row) * 2048 + n0 + c8;
      const uint4 ga = *(const uint4*)gp, gg = *(const uint4*)(gp + 1024);
      float4* sp = (float4*)(sC + row * LDC + c8);
      float4 a = sp[0], b = sp[1];
      a.x *= bf_lo(ga.x) / bf_lo(gg.x); a.y *= bf_hi(ga.x) / bf_hi(gg.x); a.z *= bf_lo(ga.y) / bf_lo(gg.y); a.w *= bf_hi(ga.y) / bf_hi(gg.y);
      b.x *= bf_lo(ga.z) / bf_lo(gg.z); b.y *= bf_hi(ga.z) / bf_hi(gg.z); b.z *= bf_lo(ga.w) / bf_lo(gg.w); b.w *= bf_hi(ga.w) / bf_hi(gg.w);
      sp[0] = a; sp[1] = b;
    }
    __syncthreads();
#pragma unroll
    for (int i = 0; i < 4; i++)
#pragma unroll
      for (int j = 0; j < 4; j++)
#pragma unroll
        for (int e = 0; e < 4; e++) acc[i][j][e] = sC[(wr * 64 + i * 16 + quad * 4 + e) * LDC + wc * 64 + j * 16 + r16];
    gemm_tile2(acc, (const u16*)(ws + OFF_OF) + (size_t)t0 * 1024, 1024, (const u16*)(ws + OFF_WGOT) + ((size_t)l * 1024 + n0) * 1024, 1024, 1024, sA);
    acc_to_lds(acc, sC);
#pragma unroll 2
    for (int i = 0; i < 8; i++) {
      const int id = i * 256 + tid, row = id >> 4, c8 = (id & 15) * 8, token = t0 + row;
      const uint4 gg = *(const uint4*)(GM + (size_t)token * 2048 + 1024 + n0 + c8);
      const float4 a = *(const float4*)(sC + row * LDC + c8), b = *(const float4*)(sC + row * LDC + c8 + 4);
      *(uint4*)((u16*)(ws + OFF_Q) + (size_t)token * 1024 + n0 + c8) =
          make_uint4(pack2(a.x * bf_lo(gg.x), a.y * bf_hi(gg.x)), pack2(a.z * bf_lo(gg.y), a.w * bf_hi(gg.y)),
                     pack2(b.x * bf_lo(gg.z), b.y * bf_hi(gg.z)), pack2(b.z * bf_lo(gg.w), b.w * bf_hi(gg.w)));
    }
  }
}

__device__ __forceinline__ void phase_gemm_out(const Params& p, int l, char* smem) {
  char* ws = p.ws;
  u16* sA = (u16*)smem; u16* sB = sA + 128 * LDT; float* sC = (float*)smem;
  const int tid = threadIdx.x;
  const float* mod = (const float*)(ws + OFF_MOD) + (size_t)l * 5 * 6144;
  for (int q = blockIdx.x >> 3; ; q += gridDim.x >> 3) {
    int mt, nt; if (!xcd_tile(q, 8, mt, nt)) break;
    const int t0 = mt * 128, n0 = nt * 128;
    f32x4 acc[4][4]; acc_zero(acc);
    gemm_tile2(acc, (const u16*)(ws + OFF_Q) + (size_t)t0 * 1024, 1024, (const u16*)(ws + OFF_WOUT) + ((size_t)l * 1024 + n0) * 1024, 1024, 1024, sA);
    acc_to_lds(acc, sC);
#pragma unroll 4
    for (int i = 0; i < 16; i++) {
      const int id = i * 256 + tid, row = id >> 5, c4 = (id & 31) * 4, token = t0 + row;
      const float4 v = *(const float4*)(sC + row * LDC + c4);
      const f32x4 xv = __builtin_nontemporal_load((const f32x4*)((const float*)(ws + OFF_X) + (size_t)token * 1024 + n0 + c4)); const float4 x = make_float4(xv.x, xv.y, xv.z, xv.w);
      const float4 g = *(const float4*)(mod + (size_t)tok_group(token) * 6144 + 2048 + n0 + c4);
      *(float4*)((float*)(ws + OFF_PRE) + (size_t)token * 1024 + n0 + c4) =
          make_float4(ALPHA * x.x + g.x * v.x, ALPHA * x.y + g.y * v.y, ALPHA * x.z + g.z * v.z, ALPHA * x.w + g.w * v.w);
    }
  }
}

__device__ __forceinline__ void phase_ln1(const Params& p, int l) {
  char* ws = p.ws;
  const int lane = threadIdx.x & 63;
  const int wv = blockIdx.x * 4 + (threadIdx.x >> 6), nw = gridDim.x * 4;
  const float* mod = (const float*)(ws + OFF_MOD) + (size_t)l * 5 * 6144;
  for (int token = wv; token < NTOK; token += nw) {
    float* row = (float*)(ws + OFF_PRE) + (size_t)token * 1024;
    float4 v[4]; float s = 0;
#pragma unroll
    for (int i = 0; i < 4; i++) { const f32x4 t = __builtin_nontemporal_load((const f32x4*)row + i * 64 + lane); v[i] = make_float4(t.x, t.y, t.z, t.w); s += v[i].x + v[i].y + v[i].z + v[i].w; }
    const float mu = wave_sum(s) * (1.f / 1024.f);
    float q = 0;
#pragma unroll
    for (int i = 0; i < 4; i++) { v[i].x -= mu; v[i].y -= mu; v[i].z -= mu; v[i].w -= mu; q += v[i].x * v[i].x + v[i].y * v[i].y + v[i].z * v[i].z + v[i].w * v[i].w; }
    const float rstd = rsqrtf(wave_sum(q) * (1.f / 1024.f) + 1e-5f);
    const float* m = mod + (size_t)tok_group(token) * 6144;
#pragma unroll
    for (int i = 0; i < 4; i++) {
      const int c = i * 256 + lane * 4;
      const float4 g = *(const float4*)(p.ln1_g + l * 1024 + c), bb = *(const float4*)(p.ln1_b + l * 1024 + c);
      float4 x; x.x = v[i].x * rstd * g.x + bb.x; x.y = v[i].y * rstd * g.y + bb.y; x.z = v[i].z * rstd * g.z + bb.z; x.w = v[i].w * rstd * g.w + bb.w;
      ((float4*)row)[i * 64 + lane] = x;
      const float4 sh = *(const float4*)(m + 3072 + c), sc = *(const float4*)(m + 4096 + c);
      *(uint2*)((u16*)(ws + OFF_H) + (size_t)token * 1024 + c) =
          make_uint2(pack2(x.x * (1.f + sc.x) + sh.x, x.y * (1.f + sc.y) + sh.y), pack2(x.z * (1.f + sc.z) + sh.z, x.w * (1.f + sc.w) + sh.w));
    }
  }
}

__device__ __forceinline__ int enc_key(float f) { const int b = __float_as_int(f); return b ^ ((b >> 31) & 0x7fffffff); }
__device__ __forceinline__ float dec_key(int s) { return __int_as_float(s ^ ((s >> 31) & 0x7fffffff)); }
#define CE_DESC(a, b) { const int _mx = max(a, b), _mn = min(a, b); a = _mx; b = _mn; }
__device__ __forceinline__ void sort16_desc(int (&k)[16]) {
#pragma unroll
  for (int size = 2; size <= 16; size <<= 1)
#pragma unroll
    for (int stride = size >> 1; stride > 0; stride >>= 1)
#pragma unroll
      for (int i = 0; i < 16; i++) {
        const int j = i ^ stride;
        if (j > i) { if ((i & size) == 0) { CE_DESC(k[i], k[j]); } else { CE_DESC(k[j], k[i]); } }
      }
}
__device__ __forceinline__ void bitonic_merge16_desc(int (&k)[16]) {
#pragma unroll
  for (int stride = 8; stride > 0; stride >>= 1)
#pragma unroll
    for (int i = 0; i < 16; i++) { const int j = i ^ stride; if (j > i) { CE_DESC(k[i], k[j]); } }
}
__device__ __forceinline__ void merge_top16(int (&a)[16], const int (&b)[16]) {
#pragma unroll
  for (int i = 0; i < 16; i++) a[i] = max(a[i], b[15 - i]);
  bitonic_merge16_desc(a);
}

__device__ __forceinline__ void phase_peerq(const Params& p, int l, char* smem) {
  char* ws = p.ws;
  u16* sA = (u16*)smem; u16* sB = sA + 128 * LDT; float* sC = (float*)smem;
  u16* sQ = (u16*)smem; u16* sS = sQ + 128 * LDQ;
  const int tid = threadIdx.x, lane = tid & 63, wid = tid >> 6, wr = wid >> 1, wc = wid & 1, r16 = lane & 15, quad = lane >> 4;
  int* S1 = (int*)(ws + OFF_S1);
  for (int q = blockIdx.x >> 3; ; q += gridDim.x >> 3) {
    int mt, hd; if (!xcd_tile(q, 8, mt, hd)) break;
    const int t0 = mt * 128;
#pragma unroll 1
    for (int pp = 0; pp < 2; pp++) {
      f32x4 acc[4][4]; acc_zero(acc);
      gemm_tile1(acc, (const u16*)(ws + OFF_H) + (size_t)t0 * 1024, 1024,
                (const u16*)(ws + OFF_WQT) + ((size_t)l * 2048 + hd * 256 + pp * 128) * 1024, 1024, 1024, sA, sB);
      __syncthreads();
#pragma unroll
      for (int i = 0; i < 4; i++)
#pragma unroll
        for (int j = 0; j < 4; j++)
#pragma unroll
          for (int e = 0; e < 4; e++) sQ[(wr * 64 + i * 16 + quad * 4 + e) * LDQ + wc * 64 + j * 16 + r16] = f2bf(acc[i][j][e]);
      {
        const u16* sk = (const u16*)(ws + OFF_SKB) + ((size_t)l * 2 + pp) * 16384;
#pragma unroll
        for (int i = 0; i < 8; i++) {
          const int ch = tid + 256 * i, rr = ch >> 4, cc = (ch & 15) * 8;
          *(uint4*)(sS + rr * LDQ + cc) = *(const uint4*)(sk + rr * 128 + cc);
        }
      }
      __syncthreads();
      acc_zero(acc);
#pragma unroll
      for (int ks = 0; ks < 4; ks++) {
        bf16x8 a[4], b[4];
#pragma unroll
        for (int i = 0; i < 4; i++) a[i] = ld8(sQ + (wr * 64 + i * 16 + r16) * LDQ + ks * 32 + quad * 8);
#pragma unroll
        for (int j = 0; j < 4; j++) b[j] = ld8(sS + (wc * 64 + j * 16 + r16) * LDQ + ks * 32 + quad * 8);
#pragma unroll
        for (int i = 0; i < 4; i++)
#pragma unroll
          for (int j = 0; j < 4; j++) acc[i][j] = MFMA16(a[i], b[j], acc[i][j]);
      }
      acc_to_lds(acc, sC);
#pragma unroll 1
      for (int pass = 0; pass < 4; pass++) {
        const int row = pass * 32 + (tid >> 3), s = tid & 7;
        int k[16];
#pragma unroll
        for (int i = 0; i < 16; i++) { const int col = s + 8 * i; k[i] = (enc_key(sC[row * LDC + col]) & ~127) | col; }
        sort16_desc(k);
#pragma unroll
        for (int m = 1; m <= 4; m <<= 1) {
          int o[16];
#pragma unroll
          for (int i = 0; i < 16; i++) o[i] = __shfl_xor(k[i], m);
          merge_top16(k, o);
        }
        if (s == 0) {
          int4* dst = (int4*)(S1 + (((size_t)(t0 + row) * 8 + hd) * 2 + pp) * 16);
          dst[0] = make_int4(k[0], k[1], k[2], k[3]); dst[1] = make_int4(k[4], k[5], k[6], k[7]);
          dst[2] = make_int4(k[8], k[9], k[10], k[11]); dst[3] = make_int4(k[12], k[13], k[14], k[15]);
        }
      }
    }
    __threadfence_block();
    __syncthreads();
    if (tid < 128) {
      const int token = t0 + tid;
      const int* l1 = S1 + (((size_t)token * 8 + hd) * 2) * 16; const int* l2 = l1 + 16;
      int k1[16], k2[16];
#pragma unroll
      for (int i = 0; i < 4; i++) {
        const int4 a = ((const int4*)l1)[i], b = ((const int4*)l2)[i];
        k1[4 * i] = a.x; k1[4 * i + 1] = a.y; k1[4 * i + 2] = a.z; k1[4 * i + 3] = a.w;
        k2[4 * i] = b.x; k2[4 * i + 1] = b.y; k2[4 * i + 2] = b.z; k2[4 * i + 3] = b.w;
      }
      float v1[16], v2[16];
#pragma unroll
      for (int i = 0; i < 16; i++) { v1[i] = dec_key(k1[i] & ~127); v2[i] = dec_key(k2[i] & ~127); }
#define FILL_GROUP(G, ARR) { int n = 0; _Pragma("unroll") for (int i = 0; i < 16; i++) _Pragma("unroll") for (int j = 0; j < 16; j++) \
        if ((i + 1) * (j + 1) <= 16) { if (n >= (G) * 16 && n < (G) * 16 + 16) ARR[n - (G) * 16] = (enc_key(v1[i] + v2[j]) & ~255) | (i << 4) | j; n++; } \
        _Pragma("unroll") for (int q = 0; q < 16; q++) if ((G) * 16 + q >= 50) ARR[q] = (int)0x80000000; }
      int g0[16], g2[16];
      {
        int g1[16];
        FILL_GROUP(0, g0); sort16_desc(g0);
        FILL_GROUP(1, g1); sort16_desc(g1);
        merge_top16(g0, g1);
      }
      {
        int g3[16];
        FILL_GROUP(2, g2); sort16_desc(g2);
        FILL_GROUP(3, g3); sort16_desc(g3);
        merge_top16(g2, g3);
      }
      merge_top16(g0, g2);
#undef FILL_GROUP
      float sc[16]; float mx = dec_key(g0[0] & ~255), sum = 0;
#pragma unroll
      for (int i = 0; i < 16; i++) { sc[i] = __expf(dec_key(g0[i] & ~255) - mx); sum += sc[i]; }
      const float inv = 1.f / sum;
      int* ei = (int*)(ws + OFF_EI) + (size_t)token * 128 + hd * 16;
      float* eg = (float*)(ws + OFF_EG) + (size_t)token * 128 + hd * 16;
      int eiv[16]; float egv[16];
#pragma unroll
      for (int i = 0; i < 16; i++) {
        const int ci = g0[i] & 255;
        const int i1 = l1[ci >> 4] & 127, i2 = l2[ci & 15] & 127;
        eiv[i] = i1 * 128 + i2;
        egv[i] = sc[i] * inv;
      }
#pragma unroll
      for (int i = 0; i < 4; i++) {
        ((int4*)ei)[i] = make_int4(eiv[4 * i], eiv[4 * i + 1], eiv[4 * i + 2], eiv[4 * i + 3]);
        ((float4*)eg)[i] = make_float4(egv[4 * i], egv[4 * i + 1], egv[4 * i + 2], egv[4 * i + 3]);
      }
    }
    __syncthreads();
  }
}

typedef __attribute__((ext_vector_type(2))) float f32x2v;
#define CV8LO(word) __builtin_amdgcn_cvt_pk_f32_fp8((int)(word), false)
#define CV8HI(word) __builtin_amdgcn_cvt_pk_f32_fp8((int)(word), true)
__device__ __forceinline__ float dot16_fp8(const f32x2v (&hx)[8], const u32x4 r) {
  f32x2v s = CV8LO(r.x) * hx[0];
  s = CV8HI(r.x) * hx[1] + s;
  s = CV8LO(r.y) * hx[2] + s; s = CV8HI(r.y) * hx[3] + s;
  s = CV8LO(r.z) * hx[4] + s; s = CV8HI(r.z) * hx[5] + s;
  s = CV8LO(r.w) * hx[6] + s; s = CV8HI(r.w) * hx[7] + s;
  return s.x + s.y;
}
__device__ __forceinline__ float transpose_reduce64(float (&s)[64], int lane) {
#pragma unroll
  for (int m = 32; m >= 1; m >>= 1) {
    const bool up = (lane & m) != 0;
#pragma unroll
    for (int i = 0; i < m; i++) {
      const float a = s[i], b = s[i + m];
      const float send = up ? a : b, keep = up ? b : a;
      s[i] = keep + __shfl_xor(send, m);
    }
  }
  return s[0];
}
__device__ __forceinline__ void phase_peer_apply(const Params& p, int l) {
  char* ws = p.ws;
  const int lane = threadIdx.x & 63;
  const int wv = blockIdx.x * 4 + (threadIdx.x >> 6), nw = gridDim.x * 4;
  const unsigned char* U = (const unsigned char*)(ws + OFF_U16) + (size_t)l * 16384 * 1024;
  const unsigned char* V = (const unsigned char*)(ws + OFF_V16) + (size_t)l * 16384 * 1024;
  const float* mod = (const float*)(ws + OFF_MOD) + (size_t)l * 5 * 6144;
  for (int token = wv; token < NTOK; token += nw) {
    const u16* hrow = (const u16*)(ws + OFF_H) + (size_t)token * 1024 + lane * 16;
    f32x2v hx[8];
    {
      const uint4 a = *(const uint4*)(hrow), b = *(const uint4*)(hrow + 8);
      hx[0] = (f32x2v){bf_lo(a.x), bf_hi(a.x)}; hx[1] = (f32x2v){bf_lo(a.y), bf_hi(a.y)}; hx[2] = (f32x2v){bf_lo(a.z), bf_hi(a.z)}; hx[3] = (f32x2v){bf_lo(a.w), bf_hi(a.w)};
      hx[4] = (f32x2v){bf_lo(b.x), bf_hi(b.x)}; hx[5] = (f32x2v){bf_lo(b.y), bf_hi(b.y)}; hx[6] = (f32x2v){bf_lo(b.z), bf_hi(b.z)}; hx[7] = (f32x2v){bf_lo(b.w), bf_hi(b.w)};
    }
    const int e0 = ((const int*)(ws + OFF_EI))[(size_t)token * 128 + lane], e1 = ((const int*)(ws + OFF_EI))[(size_t)token * 128 + 64 + lane];
    const float g0 = ((const float*)(ws + OFF_EG))[(size_t)token * 128 + lane], g1 = ((const float*)(ws + OFF_EG))[(size_t)token * 128 + 64 + lane];
    float a0, a1;
    {
      float s[64];
#pragma unroll
      for (int k = 0; k < 64; k++) {
        const int e = __builtin_amdgcn_readlane(e0, k);
        s[k] = dot16_fp8(hx, *(const u32x4*)(U + (size_t)e * 1024 + lane * 16));
      }
      a0 = transpose_reduce64(s, lane) * (1.f / 128.f);
#pragma unroll
      for (int k = 0; k < 64; k++) {
        const int e = __builtin_amdgcn_readlane(e1, k);
        s[k] = dot16_fp8(hx, *(const u32x4*)(U + (size_t)e * 1024 + lane * 16));
      }
      a1 = transpose_reduce64(s, lane) * (1.f / 128.f);
    }
    const float w0 = g0 * geluf_(a0) * (1.f / 16.f), w1 = g1 * geluf_(a1) * (1.f / 16.f);
    f32x2v acc2[8];
#pragma unroll
    for (int i = 0; i < 8; i++) acc2[i] = (f32x2v){0.f, 0.f};
#pragma unroll 8
    for (int k = 0; k < 128; k++) {
      const int e = __builtin_amdgcn_readlane(k < 64 ? e0 : e1, k & 63);
      const float wk = __builtin_bit_cast(float, __builtin_amdgcn_readlane(__builtin_bit_cast(int, k < 64 ? w0 : w1), k & 63));
      const f32x2v wk2 = (f32x2v){wk, wk};
      const u32x4 r = *(const u32x4*)(V + (size_t)e * 1024 + lane * 16);
      acc2[0] = CV8LO(r.x) * wk2 + acc2[0]; acc2[1] = CV8HI(r.x) * wk2 + acc2[1];
      acc2[2] = CV8LO(r.y) * wk2 + acc2[2]; acc2[3] = CV8HI(r.y) * wk2 + acc2[3];
      acc2[4] = CV8LO(r.z) * wk2 + acc2[4]; acc2[5] = CV8HI(r.z) * wk2 + acc2[5];
      acc2[6] = CV8LO(r.w) * wk2 + acc2[6]; acc2[7] = CV8HI(r.w) * wk2 + acc2[7];
    }
    float acc[16];
#pragma unroll
    for (int i = 0; i < 8; i++) { acc[2 * i] = acc2[i].x; acc[2 * i + 1] = acc2[i].y; }
    const float* x1 = (const float*)(ws + OFF_PRE) + (size_t)token * 1024 + lane * 16;
    const float* m = mod + (size_t)tok_group(token) * 6144 + lane * 16;
    float v[16]; float sm = 0;
#pragma unroll
    for (int q = 0; q < 4; q++) {
      const float4 x = *(const float4*)(x1 + q * 4), g = *(const float4*)(m + 5120 + q * 4);
      v[q * 4 + 0] = ALPHA * x.x + g.x * acc[q * 4 + 0]; v[q * 4 + 1] = ALPHA * x.y + g.y * acc[q * 4 + 1];
      v[q * 4 + 2] = ALPHA * x.z + g.z * acc[q * 4 + 2]; v[q * 4 + 3] = ALPHA * x.w + g.w * acc[q * 4 + 3];
    }
#pragma unroll
    for (int i = 0; i < 16; i++) sm += v[i];
    const float mu = wave_sum(sm) * (1.f / 1024.f);
    float q2 = 0;
#pragma unroll
    for (int i = 0; i < 16; i++) { v[i] -= mu; q2 += v[i] * v[i]; }
    const float rstd = rsqrtf(wave_sum(q2) * (1.f / 1024.f) + 1e-5f);
    float* xo = (l == 1 ? p.out + OUT_Y : (float*)(ws + OFF_X)) + (size_t)token * 1024 + lane * 16;
    const float* mn = (const float*)(ws + OFF_MOD) + (size_t)5 * 6144 + (size_t)tok_group(token) * 6144 + lane * 16;
    unsigned hw[8];
#pragma unroll
    for (int q = 0; q < 4; q++) {
      const float4 g = *(const float4*)(p.ln2_g + l * 1024 + lane * 16 + q * 4), bb = *(const float4*)(p.ln2_b + l * 1024 + lane * 16 + q * 4);
      float4 x;
      x.x = v[q * 4 + 0] * rstd * g.x + bb.x; x.y = v[q * 4 + 1] * rstd * g.y + bb.y;
      x.z = v[q * 4 + 2] * rstd * g.z + bb.z; x.w = v[q * 4 + 3] * rstd * g.w + bb.w;
      *(float4*)(xo + q * 4) = x;
      if (l == 0) {
        const float4 sh = *(const float4*)(mn + q * 4), sc = *(const float4*)(mn + 1024 + q * 4);
        hw[q * 2] = pack2(x.x * (1.f + sc.x) + sh.x, x.y * (1.f + sc.y) + sh.y);
        hw[q * 2 + 1] = pack2(x.z * (1.f + sc.z) + sh.z, x.w * (1.f + sc.w) + sh.w);
      }
    }
    if (l == 0) {
      u16* hd = (u16*)(ws + OFF_H) + (size_t)token * 1024 + lane * 16;
      *(uint4*)hd = make_uint4(hw[0], hw[1], hw[2], hw[3]);
      *(uint4*)(hd + 8) = make_uint4(hw[4], hw[5], hw[6], hw[7]);
    }
  }
}

__global__ void __launch_bounds__(256, 2) mega(Params p, int ph_lo, int ph_hi, int coop, int never) {
  extern __shared__ __attribute__((aligned(16))) char smem[];
  __shared__ uint4 xb_words;
  XcdBarrier xb;
  if (coop) {
    if (threadIdx.x == 0) xb_words = make_uint4(0u, 0u, 0u, 0u);
    __syncthreads();
    xb = xcd_barrier_post((unsigned*)(p.ws + OFF_BAR), (volatile LAS unsigned*)&xb_words);
    if (never) cg::this_grid().sync();
  }
#define RUN(PH, CALL) if (ph_lo <= (PH) && (PH) < ph_hi) { CALL; if (coop && (PH) + 1 < ph_hi) xcd_barrier(xb); }
#define LAYER(L) \
  RUN(2 + 9 * L + 0, phase_gemm1(p, L, smem)) \
  RUN(2 + 9 * L + 1, phase_mixa(p, L, smem)) \
  RUN(2 + 9 * L + 2, phase_mixb(p, L, smem)) \
  RUN(2 + 9 * L + 3, phase_glapost(p, L)) \
  RUN(2 + 9 * L + 4, { phase_gemm_ao(p, L, smem); if (L == 0) conv_peer_table(p, 0, 0); else conv_peer_table(p, 1, 1); }) \
  RUN(2 + 9 * L + 5, { phase_gemm_out(p, L, smem); if (L == 0) { conv_peer_table(p, 1, 0); transpose_layer1_idle(p, smem); } }) \
  RUN(2 + 9 * L + 6, phase_ln1(p, L)) \
  RUN(2 + 9 * L + 7, { phase_peerq(p, L, smem); if (L == 0) conv_peer_table(p, 0, 1); }) \
  RUN(2 + 9 * L + 8, phase_peer_apply(p, L))
  RUN(0, phase_prep(p, smem))
  RUN(1, phase_xin(p))
  LAYER(0)
  LAYER(1)
}

constexpr int SMEM_BYTES = 69632;

extern "C" void kernel_launch(void* const* d_in, const int* in_sizes, int n_in, void* d_out, int out_size, void* d_ws, size_t ws_size,
                              hipStream_t stream) {
  static int grid_blocks = 0;
  if (!grid_blocks) {
    hipFuncSetAttribute((const void*)mega, hipFuncAttributeMaxDynamicSharedMemorySize, SMEM_BYTES);
    int dev = 0, cus = 0, per_cu = 0;
    hipGetDevice(&dev);
    hipDeviceGetAttribute(&cus, hipDeviceAttributeMultiprocessorCount, dev);
    hipOccupancyMaxActiveBlocksPerMultiprocessor(&per_cu, mega, 256, SMEM_BYTES);
    if (per_cu > 2) per_cu = 2;
    if (per_cu < 1) per_cu = 1;
    grid_blocks = (cus * per_cu) & ~7;
  }
  if (ws_size < WS_NEED) { fprintf(stderr, "workspace too small: %zu < %zu\n", ws_size, (size_t)WS_NEED); return; }
  Params p{};
  const float** pp = (const float**)&p;
  for (int i = 0; i < 26; i++) pp[i] = (const float*)d_in[i];
  p.out = (float*)d_out;
  p.ws = (char*)d_ws;
  (void)hipMemsetAsync(d_ws, 0, 16384, stream);
  int ph_lo = 0, ph_hi = NPHASE, coop = 1, never = 0;
  void* args[] = {&p, &ph_lo, &ph_hi, &coop, &never};
  hipError_t e = hipLaunchCooperativeKernel((const void*)mega, dim3(grid_blocks), dim3(256), args, SMEM_BYTES, stream);
  if (e != hipSuccess) fprintf(stderr, "cooperative launch failed: %s (grid %d)\n", hipGetErrorString(e), grid_blocks);
}
```

```cpp
#include <hip/hip_runtime.h>
#include <hip/hip_cooperative_groups.h>
#include <cstdio>
#include <cstdint>
namespace cg = cooperative_groups;

typedef unsigned short u16;
typedef __attribute__((ext_vector_type(8))) short bf16x8;
typedef __attribute__((ext_vector_type(4))) float f32x4;
typedef __attribute__((ext_vector_type(4))) unsigned u32x4;
typedef __attribute__((ext_vector_type(2))) float f32x2_t;
typedef __attribute__((ext_vector_type(2))) __bf16 bf16x2_t;

constexpr int DM = 1024;
constexpr int NTOK = 12288, NCTX = 8192;
constexpr int INW = 6688, INWP = 6784;
constexpr int LKEYS = 1536;
constexpr float ALPHA = 1.4142135623730951f;
constexpr int NPHASE = 20;

constexpr size_t MB = 1024ull * 1024ull;
constexpr size_t OFF_BAR  = 0;
constexpr size_t OFF_WINT = 16384;
constexpr size_t OFF_WAOT = OFF_WINT + 2ull * INWP * 1024 * 2;
constexpr size_t OFF_WGOT = OFF_WAOT + 4 * MB;
constexpr size_t OFF_WOUT = OFF_WGOT + 4 * MB;
constexpr size_t OFF_WQT  = OFF_WOUT + 4 * MB;
constexpr size_t OFF_SKB  = OFF_WQT + 8 * MB;
constexpr size_t OFF_U16  = OFF_SKB + 131072;
constexpr size_t OFF_V16  = OFF_U16 + 32 * MB;
constexpr size_t OFF_MOD  = OFF_V16 + 32 * MB;
constexpr size_t OFF_ROPE = OFF_MOD + 262144;
constexpr size_t OFF_X    = OFF_ROPE + 262144;
constexpr size_t OFF_H    = OFF_X + 48 * MB;
constexpr size_t OFF_Q    = OFF_H + 24 * MB;
constexpr size_t OFF_KC   = OFF_Q + 24 * MB;
constexpr size_t OFF_KL   = OFF_KC + 4 * MB;
constexpr size_t OFF_VTC  = OFF_KL + 6 * MB;
constexpr size_t OFF_VTL  = OFF_VTC + 4 * MB;
constexpr size_t OFF_GQ   = OFF_VTL + 6 * MB;
constexpr size_t OFF_GK   = OFF_GQ + 12 * MB;
constexpr size_t OFF_GV   = OFF_GK + 12 * MB;
constexpr size_t OFF_GOUT = OFF_GV + 24 * MB;
constexpr size_t OFF_GLR  = OFF_GOUT + 24 * MB;
constexpr size_t OFF_GM   = OFF_GLR + 2 * MB;
constexpr size_t OFF_ATT  = OFF_GM + 48 * MB;
constexpr size_t OFF_OF   = OFF_ATT + 24 * MB;
constexpr size_t OFF_OB   = OFF_OF + 24 * MB;
constexpr size_t OFF_KT   = OFF_OB + 24 * MB;
constexpr size_t OFF_PM   = OFF_KT + 24 * MB;
constexpr size_t OFF_EBL  = OFF_PM + 12 * MB;
constexpr size_t WS_NEED  = OFF_EBL + 1 * MB;
constexpr size_t OFF_QE   = OFF_H;
constexpr size_t OFF_PRE  = OFF_GV;
constexpr size_t OFF_S1   = OFF_GM;
constexpr size_t OFF_EI   = OFF_S1 + 13 * MB;
constexpr size_t OFF_EG   = OFF_EI + 6 * MB;

struct Params {
  const float *x_prompt, *x_sample, *cache_k, *cache_v, *state_gla, *c, *c_ctx, *ada_w, *ada_b, *w_in, *q_norm, *k_norm,
      *gate_w2, *gate_b, *gla_norm, *w_attn_o, *w_gla_o, *w_out, *ln1_g, *ln1_b, *ln2_g, *ln2_b, *peer_wq, *peer_sub_keys,
      *peer_u, *peer_v;
  float* out;
  char* ws;
};

constexpr size_t OUT_Y   = 0;
constexpr size_t OUT_K   = (size_t)NTOK * DM;
constexpr size_t OUT_V   = OUT_K + 32ull * 2 * 256 * 256;
constexpr size_t OUT_S   = OUT_V + 32ull * 2 * 256 * 256;

__device__ __forceinline__ unsigned pack2(float lo, float hi) {
  f32x2_t v = {lo, hi};
  bf16x2_t b = __builtin_convertvector(v, bf16x2_t);
  return __builtin_bit_cast(unsigned, b);
}
__device__ __forceinline__ u16 f2bf(float f) { return (u16)(pack2(f, 0.f) & 0xffffu); }
__device__ __forceinline__ float bf2f(u16 h) { return __uint_as_float(((unsigned)h) << 16); }
__device__ __forceinline__ float bf_lo(unsigned u) { return __uint_as_float(u << 16); }
__device__ __forceinline__ float bf_hi(unsigned u) { return __uint_as_float(u & 0xffff0000u); }
__device__ __forceinline__ float sigmoidf_(float x) { return 1.f / (1.f + __expf(-x)); }
__device__ __forceinline__ float siluf_(float x) { return x / (1.f + __expf(-x)); }
__device__ __forceinline__ float geluf_(float x) {
  float u = 0.7978845608028654f * (x + 0.044715f * x * x * x);
  float t = 1.f - 2.f / (1.f + __expf(2.f * u));
  return 0.5f * x * (1.f + t);
}
__device__ __forceinline__ int tok_group(int token) { return token < NCTX ? 0 : 1 + ((token - NCTX) >> 10); }
__device__ __forceinline__ float wave_sum(float v) {
#pragma unroll
  for (int m = 32; m >= 1; m >>= 1) v += __shfl_xor(v, m);
  return v;
}
__device__ __forceinline__ bf16x8 mk8(uint2 a, uint2 b) {
  uint4 u = make_uint4(a.x, a.y, b.x, b.y);
  return __builtin_bit_cast(bf16x8, u);
}
__device__ __forceinline__ bf16x8 ld8(const u16* p) { return *(const bf16x8*)p; }
#define MFMA16(a, b, c) __builtin_amdgcn_mfma_f32_16x16x32_bf16((a), (b), (c), 0, 0, 0)

#define XB_TMO      128
#define XB_XCNT(j)  (256  + 64 * (j))
#define XB_XSUB(j)  (1280 + 64 * (j))
#define XB_XGEN(j)  (2304 + 64 * (j))
#define XB_TOP      3328
#define XB_TOPGEN   3392
#define XCD_BAR_WORDS 3456
#define XB_SPIN_CAP (1u << 22)
#define LAS __attribute__((address_space(3)))
__device__ __forceinline__ unsigned xb_ld(unsigned* p) { return __hip_atomic_load(p, __ATOMIC_RELAXED, __HIP_MEMORY_SCOPE_AGENT); }
__device__ __forceinline__ unsigned xb_add(unsigned* p, unsigned v) { return __hip_atomic_fetch_add(p, v, __ATOMIC_RELAXED, __HIP_MEMORY_SCOPE_AGENT); }
__device__ __forceinline__ unsigned xb_xcc_id() { return (unsigned)__builtin_amdgcn_s_getreg((3 << 11) | 20) & 0xFu; }
#define XB_SPIN(cond, bar) do { unsigned _sp = 0; while (cond) { __builtin_amdgcn_s_sleep(4); \
    if ((++_sp & 255u) == 0u) { if (xb_ld(&(bar)[XB_TMO])) break; if (_sp > XB_SPIN_CAP) { atomicAdd(&(bar)[XB_TMO], 1u); break; } } } } while (0)
struct XcdBarrier { unsigned* bar; unsigned x; volatile LAS unsigned* st; };
__device__ __forceinline__ XcdBarrier xcd_barrier_post(unsigned* bar, volatile LAS unsigned* st) {
  XcdBarrier b; b.bar = bar; b.x = xb_xcc_id(); b.st = st;
  if (threadIdx.x == 0) (void)xb_add(&bar[XB_XCNT(b.x)], 1u);
  return b;
}
__device__ __forceinline__ void xcd_barrier_complete(unsigned* bar, unsigned x, unsigned& nloc, unsigned& nx) {
  const unsigned G = gridDim.x * gridDim.y * gridDim.z;
  unsigned sum, cnt, mine, sp = 0u;
  for (;;) {
    sum = 0u; cnt = 0u; mine = 0u;
#pragma unroll
    for (unsigned j = 0; j < 16; ++j) { const unsigned c = xb_ld(&bar[XB_XCNT(j)]); sum += c; cnt += (c > 0u) ? 1u : 0u; mine = (j == x) ? c : mine; }
    if (sum == G) break;
    __builtin_amdgcn_s_sleep(1);
    if ((++sp & 255u) == 0u) { if (xb_ld(&bar[XB_TMO])) break; if (sp > XB_SPIN_CAP) { atomicAdd(&bar[XB_TMO], 1u); break; } }
  }
  nloc = mine > 0u ? mine : 1u; nx = cnt > 0u ? cnt : 1u;
}
__device__ __forceinline__ void xcd_barrier(const XcdBarrier& b) {
  asm volatile("s_waitcnt vmcnt(0)" ::: "memory");
  __syncthreads();
  if (threadIdx.x == 0) {
    unsigned* bar = b.bar;
    __builtin_amdgcn_s_waitcnt(0);
    unsigned nloc = b.st[0], nx = b.st[1];
    if (nloc == 0u) { xcd_barrier_complete(bar, b.x, nloc, nx); b.st[0] = nloc; b.st[1] = nx; }
    const unsigned old = xb_add(&bar[XB_XSUB(b.x)], 1u);
    const unsigned gen = old / nloc;
    if (old + 1u == (gen + 1u) * nloc) {
      __builtin_amdgcn_fence(__ATOMIC_RELEASE, "agent");
      asm volatile("s_waitcnt vmcnt(0)" ::: "memory");
      const unsigned og = xb_add(&bar[XB_TOP], 1u);
      const unsigned tg = og / nx;
      if (og + 1u == (tg + 1u) * nx) xb_add(&bar[XB_TOPGEN], 1u);
      else XB_SPIN(xb_ld(&bar[XB_TOPGEN]) == tg, bar);
      __builtin_amdgcn_fence(__ATOMIC_ACQUIRE, "agent");
      xb_add(&bar[XB_XGEN(b.x)], 1u);
      asm volatile("s_waitcnt vmcnt(0)" ::: "memory");
    } else {
      XB_SPIN(xb_ld(&bar[XB_XGEN(b.x)]) == gen, bar);
      __builtin_amdgcn_fence(__ATOMIC_ACQUIRE, "agent");
      asm volatile("s_waitcnt vmcnt(0)" ::: "memory");
    }
  }
  __syncthreads();
}

#define LDT 72
#define LDC 132
__device__ __forceinline__ void gemm_compute64(f32x4 (&acc)[4][4], const u16* sA, const u16* sB, int wr, int wc, int r16, int quad) {
#pragma unroll
  for (int kk = 0; kk < 2; kk++) {
    const int co = ((kk * 4 + quad) ^ (r16 & 7)) * 8;
    bf16x8 a[4], b[4];
#pragma unroll
    for (int i = 0; i < 4; i++) a[i] = ld8(sA + (wr * 64 + i * 16 + r16) * 64 + co);
#pragma unroll
    for (int j = 0; j < 4; j++) b[j] = ld8(sB + (wc * 64 + j * 16 + r16) * 64 + co);
#pragma unroll
    for (int i = 0; i < 4; i++)
#pragma unroll
      for (int j = 0; j < 4; j++) acc[i][j] = MFMA16(a[i], b[j], acc[i][j]);
  }
}
#define GT_LOAD(RA, RB, KOFF) { _Pragma("unroll") for (int i = 0; i < 4; i++) { RA[i] = *(const u32x4*)((A + ((KOFF) + i * 32 * lda)) + va); RB[i] = *(const u32x4*)((B + ((KOFF) + i * 32 * ldb)) + vb); } }
#define GT_STORE(RA, RB, BUF) { u16* _a = smem16 + (BUF) * 16384; _Pragma("unroll") for (int i = 0; i < 4; i++) { *(u32x4*)(_a + (lrow + 32 * i) * 64 + lsw) = RA[i]; *(u32x4*)(_a + 8192 + (lrow + 32 * i) * 64 + lsw) = RB[i]; } }
#define GT_COMPUTE(BUF) gemm_compute64(acc, smem16 + (BUF) * 16384, smem16 + (BUF) * 16384 + 8192, wr, wc, r16, quad)
__device__ __forceinline__ void gemm_tile(f32x4 (&acc)[4][4], const u16* __restrict__ A, int lda, const u16* __restrict__ B, int ldb,
                                          int K, u16* smem16, u16* unused_) {
  const int tid = threadIdx.x, lane = tid & 63, wid = tid >> 6, wr = wid >> 1, wc = wid & 1, r16 = lane & 15, quad = lane >> 4;
  const int lrow = tid >> 3, lkc = (tid & 7) * 8, lsw = ((tid & 7) ^ (lrow & 7)) * 8;
  const unsigned va = lrow * lda + lkc, vb = lrow * ldb + lkc;
  u32x4 ra0[4], rb0[4], ra1[4], rb1[4];
  const int nk = K >> 6;
  GT_LOAD(ra0, rb0, 0);
  GT_LOAD(ra1, rb1, 64);
  __syncthreads();
  GT_STORE(ra0, rb0, 0);
  GT_LOAD(ra0, rb0, 128);
  __syncthreads();
  for (int kt = 0; kt < nk; kt += 2) {
    GT_STORE(ra1, rb1, 1);
    { const int kn = min(kt + 3, nk - 1) * 64; GT_LOAD(ra1, rb1, kn); }
    GT_COMPUTE(0);
    __syncthreads();
    GT_STORE(ra0, rb0, 0);
    { const int kn = min(kt + 4, nk - 1) * 64; GT_LOAD(ra0, rb0, kn); }
    GT_COMPUTE(1);
    __syncthreads();
  }
}
__device__ __forceinline__ void gemm_tile2(f32x4 (&acc)[4][4], const u16* __restrict__ A, int lda, const u16* __restrict__ B, int ldb,
                                           int K, u16* smem16) {
  const int tid = threadIdx.x, lane = tid & 63, wid = tid >> 6, wr = wid >> 1, wc = wid & 1, r16 = lane & 15, quad = lane >> 4;
  const int lrow = tid >> 3, lkc = (tid & 7) * 8, lsw = ((tid & 7) ^ (lrow & 7)) * 8;
  const unsigned va = lrow * lda + lkc, vb = lrow * ldb + lkc;
  u32x4 ra0[4], rb0[4];
  const int nk = K >> 6;
  GT_LOAD(ra0, rb0, 0);
  __syncthreads();
  GT_STORE(ra0, rb0, 0);
  GT_LOAD(ra0, rb0, 64);
  __syncthreads();
  const int co0 = ((0 + quad) ^ (r16 & 7)) * 8, co1 = ((4 + quad) ^ (r16 & 7)) * 8;
#pragma unroll 1
  for (int kt = 0; kt < nk; kt++) {
    const u16* sAc = smem16 + (kt & 1) * 16384; const u16* sBc = sAc + 8192;
    bf16x8 a0[4], b0[4], a1[4], b1[4];
#pragma unroll
    for (int i = 0; i < 4; i++) { a0[i] = ld8(sAc + (wr * 64 + i * 16 + r16) * 64 + co0); a1[i] = ld8(sAc + (wr * 64 + i * 16 + r16) * 64 + co1); }
#pragma unroll
    for (int j = 0; j < 4; j++) { b0[j] = ld8(sBc + (wc * 64 + j * 16 + r16) * 64 + co0); b1[j] = ld8(sBc + (wc * 64 + j * 16 + r16) * 64 + co1); }
    __builtin_amdgcn_sched_barrier(0);
    {
      u16* _a = smem16 + ((kt + 1) & 1) * 16384;
#pragma unroll
      for (int i = 0; i < 4; i++) { *(u32x4*)(_a + (lrow + 32 * i) * 64 + lsw) = ra0[i]; *(u32x4*)(_a + 8192 + (lrow + 32 * i) * 64 + lsw) = rb0[i]; }
    }
    { const int kn = min(kt + 2, nk - 1) * 64; GT_LOAD(ra0, rb0, kn); }
    __builtin_amdgcn_sched_barrier(0);
#pragma unroll
    for (int i = 0; i < 4; i++)
#pragma unroll
      for (int j = 0; j < 4; j++) acc[i][j] = MFMA16(a0[i], b0[j], acc[i][j]);
#pragma unroll
    for (int i = 0; i < 4; i++)
#pragma unroll
      for (int j = 0; j < 4; j++) acc[i][j] = MFMA16(a1[i], b1[j], acc[i][j]);
    __syncthreads();
  }
}
__device__ __forceinline__ void gemm_tile1(f32x4 (&acc)[4][4], const u16* __restrict__ A, int lda, const u16* __restrict__ B, int ldb,
                                           int K, u16* smem16, u16* unused_) {
  const int tid = threadIdx.x, lane = tid & 63, wid = tid >> 6, wr = wid >> 1, wc = wid & 1, r16 = lane & 15, quad = lane >> 4;
  const int lrow = tid >> 3, lkc = (tid & 7) * 8, lsw = ((tid & 7) ^ (lrow & 7)) * 8;
  const unsigned va = lrow * lda + lkc, vb = lrow * ldb + lkc;
  u32x4 ra0[4], rb0[4];
  const int nk = K >> 6;
  GT_LOAD(ra0, rb0, 0);
  __syncthreads();
  GT_STORE(ra0, rb0, 0);
  GT_LOAD(ra0, rb0, 64);
  __syncthreads();
  for (int kt = 0; kt < nk; kt += 2) {
    GT_STORE(ra0, rb0, 1);
    { const int kn = min(kt + 2, nk - 1) * 64; GT_LOAD(ra0, rb0, kn); }
    GT_COMPUTE(0);
    __syncthreads();
    GT_STORE(ra0, rb0, 0);
    { const int kn = min(kt + 3, nk - 1) * 64; GT_LOAD(ra0, rb0, kn); }
    GT_COMPUTE(1);
    __syncthreads();
  }
}
__device__ __forceinline__ void acc_zero(f32x4 (&acc)[4][4]) {
#pragma unroll
  for (int i = 0; i < 4; i++)
#pragma unroll
    for (int j = 0; j < 4; j++) acc[i][j] = (f32x4){0.f, 0.f, 0.f, 0.f};
}
__device__ __forceinline__ void acc_to_lds(const f32x4 (&acc)[4][4], float* sC) {
  const int tid = threadIdx.x, lane = tid & 63, wid = tid >> 6, wr = wid >> 1, wc = wid & 1, r16 = lane & 15, quad = lane >> 4;
  __syncthreads();
#pragma unroll
  for (int i = 0; i < 4; i++)
#pragma unroll
    for (int j = 0; j < 4; j++)
#pragma unroll
      for (int e = 0; e < 4; e++) sC[(wr * 64 + i * 16 + quad * 4 + e) * LDC + wc * 64 + j * 16 + r16] = acc[i][j][e];
  __syncthreads();
}
__device__ __forceinline__ void load_row64(float (&v)[64], const float* sC, int row, int half) {
  const float4* s = (const float4*)(sC + row * LDC + half * 64);
#pragma unroll
  for (int i = 0; i < 16; i++) { float4 t = s[i]; v[4 * i] = t.x; v[4 * i + 1] = t.y; v[4 * i + 2] = t.z; v[4 * i + 3] = t.w; }
}
__device__ __forceinline__ void store64_bf16(u16* dst, const float (&v)[64]) {
#pragma unroll
  for (int i = 0; i < 8; i++) {
    uint4 w = make_uint4(pack2(v[8 * i], v[8 * i + 1]), pack2(v[8 * i + 2], v[8 * i + 3]), pack2(v[8 * i + 4], v[8 * i + 5]), pack2(v[8 * i + 6], v[8 * i + 7]));
    ((uint4*)dst)[i] = w;
  }
}
__device__ __forceinline__ void store64_f32(float* dst, const float (&v)[64]) {
#pragma unroll
  for (int i = 0; i < 16; i++) ((float4*)dst)[i] = make_float4(v[4 * i], v[4 * i + 1], v[4 * i + 2], v[4 * i + 3]);
}

__device__ __forceinline__ bool xcd_tile(int q, int ncol, int& mt, int& nt) {
  const int x = blockIdx.x & 7;
  if (q >= 12 * ncol) return false;
  nt = q / 12; mt = (q % 12) * 8 + x;
  return true;
}
__device__ __forceinline__ void transpose_item(const Params& p, int item, char* smem) {
  char* ws = p.ws; const int tid = threadIdx.x; u16* tt = (u16*)smem;
      const int l = item / 1476, r = item % 1476, grp = r >> 2, kq = r & 3;
      const float* S; int sN, n0, drow0; u16* Dst;
      if (grp < 209) { S = p.w_in + (size_t)l * 1024 * INW; sN = INW; n0 = grp * 32; drow0 = grp < 145 ? n0 : n0 + 96; Dst = (u16*)(ws + OFF_WINT) + (size_t)l * INWP * 1024; }
      else if (grp < 241) { S = p.w_attn_o + (size_t)l * 1048576; sN = 1024; n0 = (grp - 209) * 32; drow0 = n0; Dst = (u16*)(ws + OFF_WAOT) + (size_t)l * 1048576; }
      else if (grp < 273) { S = p.w_gla_o + (size_t)l * 1048576; sN = 1024; n0 = (grp - 241) * 32; drow0 = n0; Dst = (u16*)(ws + OFF_WGOT) + (size_t)l * 1048576; }
      else if (grp < 305) { S = p.w_out + (size_t)l * 1048576; sN = 1024; n0 = (grp - 273) * 32; drow0 = n0; Dst = (u16*)(ws + OFF_WOUT) + (size_t)l * 1048576; }
      else { S = p.peer_wq + (size_t)l * 2097152; sN = 2048; n0 = (grp - 305) * 32; drow0 = n0; Dst = (u16*)(ws + OFF_WQT) + (size_t)l * 2097152; }
      const int k0 = kq * 256;
      const int rr = tid >> 3, c4 = tid & 7;
      __syncthreads();
#pragma unroll
      for (int it = 0; it < 8; it++) {
        const int k = it * 32 + rr;
        const f32x4 v = __builtin_nontemporal_load((const f32x4*)(S + (size_t)(k0 + k) * sN + n0 + c4 * 4));
        tt[(c4 * 4 + 0) * 264 + k] = f2bf(v.x); tt[(c4 * 4 + 1) * 264 + k] = f2bf(v.y);
        tt[(c4 * 4 + 2) * 264 + k] = f2bf(v.z); tt[(c4 * 4 + 3) * 264 + k] = f2bf(v.w);
      }
      __syncthreads();
#pragma unroll
      for (int it = 0; it < 4; it++) {
        const int ch = c4 + 8 * it;
        *(uint4*)(Dst + (size_t)(drow0 + rr) * 1024 + k0 + ch * 8) = *(const uint4*)(tt + rr * 264 + ch * 8);
      }
}
__device__ __forceinline__ void transpose_layer1_idle(const Params& p, char* smem) {
  const int j = blockIdx.x >> 3, x = blockIdx.x & 7, nj = gridDim.x >> 3, jh = nj >> 1, nconv = nj - jh;
  if (j < jh) return;
  const int part = x * nconv + (j - jh), nparts = 8 * nconv;
  __syncthreads();
  for (int item = 1476 + part; item < 2952; item += nparts) transpose_item(p, item, smem);
  __syncthreads();
}
__device__ __forceinline__ void conv_peer_table(const Params& p, int which, int lay) {
  const int j = blockIdx.x >> 3, x = blockIdx.x & 7, nj = gridDim.x >> 3, jh = nj >> 1, nconv = nj - jh;
  if (j < jh) return;
  const int part = x * nconv + (j - jh), nparts = 8 * nconv;
  const float* src = (which == 0 ? p.peer_u : p.peer_v) + (size_t)lay * 16384 * 1024;
  char* dstb = p.ws + (which == 0 ? OFF_U16 : OFF_V16) + (size_t)lay * 16384 * 1024;
  const float sc = which == 0 ? 128.f : 16.f;
  const size_t nch = 16384ull * 1024 / 8, per = (nch + nparts - 1) / nparts;
  const size_t c0 = (size_t)part * per, c1 = c0 + per < nch ? c0 + per : nch;
  for (size_t i = c0 + threadIdx.x; i < c1; i += 256) {
    const f32x4 a = __builtin_nontemporal_load((const f32x4*)src + 2 * i), b = __builtin_nontemporal_load((const f32x4*)src + 2 * i + 1);
    int lo = 0, hi = 0;
    lo = __builtin_amdgcn_cvt_pk_fp8_f32(a.x * sc, a.y * sc, lo, false); lo = __builtin_amdgcn_cvt_pk_fp8_f32(a.z * sc, a.w * sc, lo, true);
    hi = __builtin_amdgcn_cvt_pk_fp8_f32(b.x * sc, b.y * sc, hi, false); hi = __builtin_amdgcn_cvt_pk_fp8_f32(b.z * sc, b.w * sc, hi, true);
    ((int2*)dstb)[i] = make_int2(lo, hi);
  }
}
__device__ __forceinline__ void phase_prep(const Params& p, char* smem) {
  const int tid = threadIdx.x;
  const int G = gridDim.x;
  const size_t gtid = (size_t)blockIdx.x * 256 + tid, gsz = (size_t)G * 256;
  char* ws = p.ws;
  for (int item = blockIdx.x; item < 1476; item += G) transpose_item(p, item, smem);
  __syncthreads();
  for (size_t i = gtid; i < 2ull * 96 * 128; i += gsz) {
    const int l = (int)(i / (96 * 128)); const size_t r = i % (96 * 128);
    ((uint4*)((u16*)(ws + OFF_WINT) + ((size_t)l * INWP + 4640) * 1024))[r] = make_uint4(0, 0, 0, 0);
  }
  {
    for (size_t i = gtid; i < 65536 / 8; i += gsz) {
      const float4 a = ((const float4*)p.peer_sub_keys)[2 * i], b = ((const float4*)p.peer_sub_keys)[2 * i + 1];
      ((uint4*)(ws + OFF_SKB))[i] = make_uint4(pack2(a.x, a.y), pack2(a.z, a.w), pack2(b.x, b.y), pack2(b.z, b.w));
    }
  }
  for (size_t i = gtid; i < 32768; i += gsz) {
    const int pos = (int)(i >> 5), j = (int)(i & 31), a = j >> 4, f = j & 15;
    const float coord = (float)(a == 0 ? (pos >> 6) : (pos & 63));
    const float inv = exp2f(-(float)f * (13.287712379549449f / 16.f));
    const float ang = coord * inv;
    ((float*)(ws + OFF_ROPE))[i] = cosf(ang);
    ((float*)(ws + OFF_ROPE))[32768 + i] = sinf(ang);
  }
  for (size_t i = gtid; i < 4ull * 2 * 512 * 256; i += gsz) {
    const int d = (int)(i & 63), kvh = (int)((i >> 6) & 3), j = (int)((i >> 8) & 511), l = (int)((i >> 17) & 1), b = (int)(i >> 18);
    ((u16*)(ws + OFF_KL))[(((size_t)l * 4 + b) * LKEYS + 1024 + j) * 256 + kvh * 64 + d] = f2bf(p.cache_k[i]);
    ((u16*)(ws + OFF_VTL))[((((size_t)l * 4 + b) * 4 + kvh) * 64 + d) * LKEYS + 1024 + j] = f2bf(p.cache_v[i]);
  }
  {
    float* sc = (float*)smem;
    float* red = (float*)(smem + 20480);
    for (int item = blockIdx.x; item < 384; item += G) {
      const int l = item / 192, n0 = (item % 192) * 32;
      __syncthreads();
      for (int i = tid; i < 5120; i += 256) {
        const int g = i >> 10, k = i & 1023;
        const float cv = g == 0 ? p.c_ctx[k] : p.c[(g - 1) * 1024 + k];
        sc[i] = siluf_(cv);
      }
      __syncthreads();
      const int c = tid & 31, kg = tid >> 5;
      float a0 = 0, a1 = 0, a2 = 0, a3 = 0, a4 = 0;
      const float* w = p.ada_w + ((size_t)l * 1024 + kg * 128) * 6144 + n0 + c;
      const float* s0 = sc + kg * 128;
#pragma unroll 8
      for (int k = 0; k < 128; k++) {
        const float wv = __builtin_nontemporal_load(w + (size_t)k * 6144);
        a0 += s0[k] * wv; a1 += s0[1024 + k] * wv; a2 += s0[2048 + k] * wv; a3 += s0[3072 + k] * wv; a4 += s0[4096 + k] * wv;
      }
      red[(kg * 5 + 0) * 32 + c] = a0; red[(kg * 5 + 1) * 32 + c] = a1; red[(kg * 5 + 2) * 32 + c] = a2;
      red[(kg * 5 + 3) * 32 + c] = a3; red[(kg * 5 + 4) * 32 + c] = a4;
      __syncthreads();
      if (tid < 160) {
        const int g = tid >> 5, cc = tid & 31;
        float s = 0;
#pragma unroll
        for (int q = 0; q < 8; q++) s += red[(q * 5 + g) * 32 + cc];
        ((float*)(ws + OFF_MOD))[((size_t)l * 5 + g) * 6144 + n0 + cc] = s + p.ada_b[(size_t)l * 6144 + n0 + cc];
      }
    }
    __syncthreads();
  }
}

__device__ __forceinline__ void phase_xin(const Params& p) {
  const size_t gtid = (size_t)blockIdx.x * 256 + threadIdx.x, gsz = (size_t)gridDim.x * 256;
  const float* mod = (const float*)(p.ws + OFF_MOD);
  for (size_t i = gtid; i < (size_t)NTOK * 256; i += gsz) {
    const int token = (int)(i >> 8), c = (int)(i & 255) * 4;
    const f32x4 xv = token < NCTX ? __builtin_nontemporal_load((const f32x4*)p.x_prompt + i) : __builtin_nontemporal_load((const f32x4*)p.x_sample + (i - (size_t)NCTX * 256));
    const float4 x = make_float4(xv.x, xv.y, xv.z, xv.w);
    ((float4*)(p.ws + OFF_X))[i] = x;
    const float* m = mod + (size_t)tok_group(token) * 6144;
    const float4 sh = *(const float4*)(m + c), sc = *(const float4*)(m + 1024 + c);
    uint2 w = make_uint2(pack2(x.x * (1.f + sc.x) + sh.x, x.y * (1.f + sc.y) + sh.y), pack2(x.z * (1.f + sc.z) + sh.z, x.w * (1.f + sc.w) + sh.w));
    ((uint2*)(p.ws + OFF_H))[i] = w;
  }
}

__device__ __forceinline__ void phase_gemm1(const Params& p, int l, char* smem) {
  char* ws = p.ws;
  u16* sA = (u16*)smem; u16* sB = sA + 128 * LDT; float* sC = (float*)smem;
  const int tid = threadIdx.x;
  const u16* H = (const u16*)(ws + OFF_H);
  const u16* W = (const u16*)(ws + OFF_WINT) + (size_t)l * INWP * 1024;
  const float* ropeC = (const float*)(ws + OFF_ROPE); const float* ropeS = ropeC + 32768;
  unsigned* qctr = (unsigned*)(ws + OFF_BAR) + 3712 + (l * 8 + (blockIdx.x & 7)) * 16;
  __shared__ int s_q1;
  for (int q = blockIdx.x >> 3; ; ) {
    int mt, nt; if (!xcd_tile(q, 53, mt, nt)) break;
    const int t0 = mt * 128;
    f32x4 acc[4][4]; acc_zero(acc);
    gemm_tile2(acc, H + (size_t)t0 * 1024, 1024, W + (size_t)nt * 128 * 1024, 1024, 1024, sA);
    acc_to_lds(acc, sC);
    const int row = tid >> 1, half = tid & 1, token = t0 + row;
    const bool lat = t0 >= NCTX;
    const int bb = lat ? (t0 - NCTX) >> 10 : t0 >> 8;
    const int pos = lat ? (token - NCTX) & 1023 : token & 255;
    const int pos0 = lat ? (t0 - NCTX) & 1023 : t0 & 255;
    if (nt < 10) {
      float v[64]; load_row64(v, sC, row, half);
      float ss = 0;
#pragma unroll
      for (int c = 0; c < 64; c++) ss += v[c] * v[c];
      const float r = rsqrtf(ss * (1.f / 64.f) + 1e-6f) * (nt < 8 ? 0.125f : 1.f);
      const float* nw = (nt < 8 ? p.q_norm : p.k_norm) + l * 64;
#pragma unroll
      for (int c = 0; c < 64; c++) v[c] = v[c] * r * nw[c];
      if (lat) {
        const float* cp = ropeC + pos * 32; const float* sp = ropeS + pos * 32;
#pragma unroll
        for (int a = 0; a < 2; a++)
#pragma unroll
          for (int f = 0; f < 16; f++) {
            const float cs = cp[a * 16 + f], sn = sp[a * 16 + f];
            const float x1 = v[a * 32 + f], x2 = v[a * 32 + 16 + f];
            v[a * 32 + f] = x1 * cs - x2 * sn; v[a * 32 + 16 + f] = x2 * cs + x1 * sn;
          }
      }
      {
        float4* d = (float4*)(sC + row * LDC + half * 64);
#pragma unroll
        for (int i = 0; i < 16; i++) d[i] = make_float4(v[4 * i], v[4 * i + 1], v[4 * i + 2], v[4 * i + 3]);
      }
      __syncthreads();
      u16* dst; size_t rstride;
      if (nt < 8) { dst = (u16*)(ws + OFF_Q) + (size_t)t0 * 1024 + nt * 128; rstride = 1024; }
      else if (!lat) { dst = (u16*)(ws + OFF_KC) + (size_t)t0 * 256 + (nt - 8) * 128; rstride = 256; }
      else { dst = (u16*)(ws + OFF_KL) + (((size_t)l * 4 + bb) * LKEYS + pos0) * 256 + (nt - 8) * 128; rstride = 256; }
#pragma unroll 2
      for (int i = 0; i < 8; i++) {
        const int id = i * 256 + tid, rr = id >> 4, c8 = (id & 15) * 8;
        const float4 a = *(const float4*)(sC + rr * LDC + c8), b2 = *(const float4*)(sC + rr * LDC + c8 + 4);
        *(uint4*)(dst + (size_t)rr * rstride + c8) = make_uint4(pack2(a.x, a.y), pack2(a.z, a.w), pack2(b2.x, b2.y), pack2(b2.z, b2.w));
      }
      if (nt >= 8 && !lat) {
        float* ok = p.out + OUT_K + (((size_t)bb * 2 + l) * 256 + pos0) * 256 + (nt - 8) * 128;
#pragma unroll 4
        for (int i = 0; i < 16; i++) {
          const int id = i * 256 + tid, rr = id >> 5, c4 = (id & 31) * 4;
          *(float4*)(ok + (size_t)rr * 256 + c4) = *(const float4*)(sC + rr * LDC + c4);
        }
      }
    } else if (nt < 12) {
      if (!lat) {
        float* ov = p.out + OUT_V + (((size_t)bb * 2 + l) * 256 + pos0) * 256 + (nt - 10) * 128;
#pragma unroll 4
        for (int i = 0; i < 16; i++) {
          const int id = i * 256 + tid, rr = id >> 5, c4 = (id & 31) * 4;
          *(float4*)(ov + (size_t)rr * 256 + c4) = *(const float4*)(sC + rr * LDC + c4);
        }
      }
#pragma unroll 2
      for (int i = 0; i < 8; i++) {
        const int id = i * 256 + tid, col = id >> 4, tc = id & 15, kvh = (nt - 10) * 2 + (col >> 6), d = col & 63;
        const float* sp = sC + (tc * 8) * LDC + col;
        u16* dst = lat ? (u16*)(ws + OFF_VTL) + ((((size_t)l * 4 + bb) * 4 + kvh) * 64 + d) * LKEYS + pos0 + tc * 8
                       : (u16*)(ws + OFF_VTC) + (((size_t)bb * 4 + kvh) * 64 + d) * 256 + pos0 + tc * 8;
        *(uint4*)dst = make_uint4(pack2(sp[0], sp[LDC]), pack2(sp[2 * LDC], sp[3 * LDC]), pack2(sp[4 * LDC], sp[5 * LDC]), pack2(sp[6 * LDC], sp[7 * LDC]));
      }
    } else if (nt == 36) {
      if (half == 0) {
        const float4* s4 = (const float4*)(sC + row * LDC);
        float4* dst = (float4*)((float*)(ws + OFF_GLR) + (size_t)token * 32);
#pragma unroll
        for (int i = 0; i < 8; i++) dst[i] = s4[i];
      }
    } else if (nt >= 20 && nt < 28) {
#pragma unroll 2
      for (int i = 0; i < 8; i++) {
        const int id = i * 256 + tid, th = id >> 10, col = (id >> 3) & 127, tc = id & 7;
        const float* sp = sC + (th * 64 + tc * 8) * LDC + col;
        *(uint4*)((u16*)(ws + OFF_GV) + ((size_t)((t0 >> 6) + th) * 1024 + (nt - 20) * 128 + col) * 64 + tc * 8) =
            make_uint4(pack2(sp[0], sp[LDC]), pack2(sp[2 * LDC], sp[3 * LDC]), pack2(sp[4 * LDC], sp[5 * LDC]), pack2(sp[6 * LDC], sp[7 * LDC]));
      }
    } else {
      u16* dst; size_t rstride; int mode;
      if (nt < 16) { dst = (u16*)(ws + OFF_GQ) + (size_t)t0 * 512 + (nt - 12) * 128; rstride = 512; mode = 1; }
      else if (nt < 20) { dst = (u16*)(ws + OFF_GK) + (size_t)t0 * 512 + (nt - 16) * 128; rstride = 512; mode = 0; }
      else if (nt < 36) { dst = (u16*)(ws + OFF_GOUT) + (size_t)t0 * 1024 + (nt - 28) * 128; rstride = 1024; mode = 0; }
      else { dst = (u16*)(ws + OFF_GM) + (size_t)t0 * 2048 + (nt - 37) * 128; rstride = 2048; mode = 2; }
#pragma unroll 2
      for (int i = 0; i < 8; i++) {
        const int id = i * 256 + tid, rr = id >> 4, c8 = (id & 15) * 8;
        float4 a = *(const float4*)(sC + rr * LDC + c8), b2 = *(const float4*)(sC + rr * LDC + c8 + 4);
        if (mode == 1) { a.x *= 0.08838834764831845f; a.y *= 0.08838834764831845f; a.z *= 0.08838834764831845f; a.w *= 0.08838834764831845f;
                         b2.x *= 0.08838834764831845f; b2.y *= 0.08838834764831845f; b2.z *= 0.08838834764831845f; b2.w *= 0.08838834764831845f; }
        if (mode == 2) { a.x = sigmoidf_(a.x); a.y = sigmoidf_(a.y); a.z = sigmoidf_(a.z); a.w = sigmoidf_(a.w);
                         b2.x = sigmoidf_(b2.x); b2.y = sigmoidf_(b2.y); b2.z = sigmoidf_(b2.z); b2.w = sigmoidf_(b2.w); }
        *(uint4*)(dst + (size_t)rr * rstride + c8) = make_uint4(pack2(a.x, a.y), pack2(a.z, a.w), pack2(b2.x, b2.y), pack2(b2.z, b2.w));
      }
    }
    __syncthreads();
    if (tid == 0) s_q1 = (int)(gridDim.x >> 3) + (int)atomicAdd(qctr, 1u);
    __syncthreads();
    q = s_q1;
  }
}

__device__ __forceinline__ void attn_item(const Params& p, int l, int item, char* smem) {
  char* ws = p.ws;
  const int tid = threadIdx.x, lane = tid & 63, w = tid >> 6, r16 = lane & 15, quad = lane >> 4;
  int tok0, h, qb, nkeys, vstride; const u16* kptr; const u16* vptr;
  if (item < 512) {
    const int b = item >> 7; h = (item >> 3) & 15; qb = item & 7; tok0 = NCTX + b * 1024; nkeys = LKEYS; vstride = LKEYS;
    kptr = (const u16*)(ws + OFF_KL) + ((size_t)l * 4 + b) * LKEYS * 256 + (h >> 2) * 64;
    vptr = (const u16*)(ws + OFF_VTL) + (((size_t)l * 4 + b) * 4 + (h >> 2)) * 64 * LKEYS;
  } else {
    const int it = item - 512; const int b = it >> 5; h = (it >> 1) & 15; qb = it & 1; tok0 = b * 256; nkeys = 256; vstride = 256;
    kptr = (const u16*)(ws + OFF_KC) + (size_t)b * 256 * 256 + (h >> 2) * 64;
    vptr = (const u16*)(ws + OFF_VTC) + ((size_t)b * 4 + (h >> 2)) * 64 * 256;
  }
  const int qrow0 = tok0 + qb * 128 + w * 32;
  const u16* qptr = (const u16*)(ws + OFF_Q) + (size_t)qrow0 * 1024 + h * 64;
  bf16x8 qf[2][2];
#pragma unroll
  for (int qt = 0; qt < 2; qt++)
#pragma unroll
    for (int dh = 0; dh < 2; dh++) qf[qt][dh] = ld8(qptr + (size_t)(qt * 16 + r16) * 1024 + dh * 32 + quad * 8);
  f32x4 o[4][2];
#pragma unroll
  for (int dt = 0; dt < 4; dt++) { o[dt][0] = (f32x4){0, 0, 0, 0}; o[dt][1] = (f32x4){0, 0, 0, 0}; }
  float mrow[2] = {-1e30f, -1e30f}, lrow[2] = {0.f, 0.f};
  const int lr = tid >> 3, lc = (tid & 7) * 8;
  u32x4 rk[2], rv[2];
  const int nkb = nkeys >> 6;
#define AT_LOAD(KB) { _Pragma("unroll") for (int i = 0; i < 2; i++) { \
      rk[i] = *(const u32x4*)(kptr + (size_t)((KB) * 64 + lr + 32 * i) * 256 + lc); \
      rv[i] = *(const u32x4*)(vptr + (size_t)(lr + 32 * i) * vstride + (KB) * 64 + lc); } }
#define AT_STORE(BUF) { u16* _k = sK0 + (BUF) * (128 * LDT); _Pragma("unroll") for (int i = 0; i < 2; i++) { *(u32x4*)(_k + (lr + 32 * i) * LDT + lc) = rk[i]; *(u32x4*)(_k + 64 * LDT + (lr + 32 * i) * LDT + lc) = rv[i]; } }
  u16* const sK0 = (u16*)smem;
  AT_LOAD(0);
  __syncthreads();
  AT_STORE(0);
  AT_LOAD(1);
  __syncthreads();
  for (int kb = 0; kb < nkb; kb++) {
    AT_STORE((kb + 1) & 1);
    { const int kn = min(kb + 2, nkb - 1); AT_LOAD(kn); }
    const u16* sK = sK0 + (kb & 1) * (128 * LDT);
    const u16* sV = sK + 64 * LDT;
    f32x4 st[4][2];
#pragma unroll
    for (int kt = 0; kt < 4; kt++) {
      const bf16x8 k0 = ld8(sK + (kt * 16 + r16) * LDT + quad * 8), k1 = ld8(sK + (kt * 16 + r16) * LDT + 32 + quad * 8);
#pragma unroll
      for (int qt = 0; qt < 2; qt++) {
        f32x4 z = (f32x4){0, 0, 0, 0};
        z = MFMA16(k0, qf[qt][0], z);
        z = MFMA16(k1, qf[qt][1], z);
        st[kt][qt] = z;
      }
    }
    bf16x8 pb[2][2];
#pragma unroll
    for (int qt = 0; qt < 2; qt++) {
      float mx = -1e30f;
#pragma unroll
      for (int kt = 0; kt < 4; kt++)
#pragma unroll
        for (int e = 0; e < 4; e++) { st[kt][qt][e] *= 1.4426950408889634f; mx = fmaxf(mx, st[kt][qt][e]); }
      mx = fmaxf(mx, __shfl_xor(mx, 16)); mx = fmaxf(mx, __shfl_xor(mx, 32));
      const float mn = fmaxf(mrow[qt], mx);
      const float alpha = __builtin_amdgcn_exp2f(mrow[qt] - mn);
      mrow[qt] = mn;
      float rs = 0;
#pragma unroll
      for (int kt = 0; kt < 4; kt++)
#pragma unroll
        for (int e = 0; e < 4; e++) { const float pv = __builtin_amdgcn_exp2f(st[kt][qt][e] - mn); st[kt][qt][e] = pv; rs += pv; }
      lrow[qt] = lrow[qt] * alpha + rs;
#pragma unroll
      for (int dt = 0; dt < 4; dt++) o[dt][qt] *= alpha;
#pragma unroll
      for (int kh = 0; kh < 2; kh++) {
        uint4 u = make_uint4(pack2(st[2 * kh][qt][0], st[2 * kh][qt][1]), pack2(st[2 * kh][qt][2], st[2 * kh][qt][3]),
                             pack2(st[2 * kh + 1][qt][0], st[2 * kh + 1][qt][1]), pack2(st[2 * kh + 1][qt][2], st[2 * kh + 1][qt][3]));
        pb[qt][kh] = __builtin_bit_cast(bf16x8, u);
      }
    }
#pragma unroll
    for (int dt = 0; dt < 4; dt++)
#pragma unroll
      for (int kh = 0; kh < 2; kh++) {
        const u16* vp = sV + (dt * 16 + r16) * LDT + kh * 32 + quad * 4;
        const bf16x8 vf = mk8(*(const uint2*)vp, *(const uint2*)(vp + 16));
        o[dt][0] = MFMA16(vf, pb[0][kh], o[dt][0]);
        o[dt][1] = MFMA16(vf, pb[1][kh], o[dt][1]);
      }
    __syncthreads();
  }
#undef AT_LOAD
#undef AT_STORE
  u16* att = (u16*)(ws + OFF_ATT);
#pragma unroll
  for (int qt = 0; qt < 2; qt++) {
    float lt = lrow[qt];
    lt += __shfl_xor(lt, 16); lt += __shfl_xor(lt, 32);
    const float inv = 1.f / lt;
#pragma unroll
    for (int dt = 0; dt < 4; dt++) {
      uint2 u = make_uint2(pack2(o[dt][qt][0] * inv, o[dt][qt][1] * inv), pack2(o[dt][qt][2] * inv, o[dt][qt][3] * inv));
      *(uint2*)(att + (size_t)(qrow0 + qt * 16 + r16) * 1024 + h * 64 + dt * 16 + quad * 4) = u;
    }
  }
}

#define LDQ 136
__device__ __forceinline__ void gla_prep_item(const Params& p, int l, int item, char* smem) {
  char* ws = p.ws;
  u16* sQE = (u16*)smem;
  u16* sKE = sQE + 64 * LDQ;
  u16* sKT = sKE + 64 * LDQ;
  float* sGLR = (float*)(sKT + 128 * LDT);
  float* sTot = sGLR + 1024;
  const int tid = threadIdx.x, lane = tid & 63, w = tid >> 6, r16 = lane & 15, quad = lane >> 4;
  const int c = item >> 3, h = (item >> 1) & 3, dir = item & 1;
  const int tb = c * 64;
  const u16* GQ = (const u16*)(ws + OFF_GQ); const u16* GK = (const u16*)(ws + OFF_GK);
  const float* GLR = (const float*)(ws + OFF_GLR);
  {
    const int tk = tid >> 2, r4 = (tid & 3) * 4;
    *(float4*)(sGLR + tk * 16 + r4) = *(const float4*)(GLR + (size_t)(tb + tk) * 32 + dir * 16 + r4);
#pragma unroll
    for (int i = 0; i < 4; i++) {
      const int ch = tid + 256 * i, rr = ch >> 4, cc = (ch & 15) * 8;
      *(uint4*)(sQE + rr * LDQ + cc) = *(const uint4*)(GQ + (size_t)(tb + rr) * 512 + h * 128 + cc);
      *(uint4*)(sKE + rr * LDQ + cc) = *(const uint4*)(GK + (size_t)(tb + rr) * 512 + h * 128 + cc);
    }
  }
  __syncthreads();
#pragma unroll 1
  for (int dh = 0; dh < 2; dh++) {
    const int dk = dh * 64 + lane, qtr = w;
    float la[16];
    float tot = 0;
    {
      float w2r[16];
#pragma unroll
      for (int r = 0; r < 16; r++) w2r[r] = p.gate_w2[(((size_t)l * 2 + dir) * 16 + r) * 512 + h * 128 + dk];
      const float gb = p.gate_b[((size_t)l * 2 + dir) * 512 + h * 128 + dk];
#pragma unroll
      for (int tt = 0; tt < 16; tt++) {
        const float* g = sGLR + (qtr * 16 + tt) * 16;
        float z = gb;
#pragma unroll
        for (int r = 0; r < 16; r++) z += g[r] * w2r[r];
        const float ls = fminf(z, 0.f) - __logf(1.f + __expf(-fabsf(z)));
        la[tt] = ls * (1.f / 16.f);
        tot += la[tt];
      }
    }
    sTot[qtr * 128 + dk] = tot;
    __syncthreads();
    const float q0 = sTot[dk], q1 = sTot[128 + dk], q2 = sTot[256 + dk], q3 = sTot[384 + dk];
    const float bl = (q0 + q1) + (q2 + q3);
    float run;
    if (dir == 0) {
      run = qtr == 0 ? 0.f : qtr == 1 ? q0 : qtr == 2 ? q0 + q1 : q0 + q1 + q2;
#pragma unroll
      for (int tt = 0; tt < 16; tt++) { run += la[tt]; la[tt] = run; }
    } else {
      run = qtr == 3 ? 0.f : qtr == 2 ? q3 : qtr == 1 ? q3 + q2 : q3 + q2 + q1;
#pragma unroll
      for (int tt = 15; tt >= 0; tt--) { run += la[tt]; la[tt] = run; }
    }
    if (qtr == 0) ((float*)(ws + OFF_EBL))[(size_t)item * 128 + dk] = __expf(bl);
#pragma unroll
    for (int tt = 0; tt < 16; tt++) {
      const int tk = qtr * 16 + tt;
      const float q = bf2f(sQE[tk * LDQ + dk]);
      const float k = bf2f(sKE[tk * LDQ + dk]);
      const float bb = la[tt];
      sQE[tk * LDQ + dk] = f2bf(q * __expf(bb));
      sKE[tk * LDQ + dk] = f2bf(k * __expf(-bb));
      sKT[dk * LDT + tk] = f2bf(k * __expf(bl - bb));
    }
  }
  __syncthreads();
  {
    bf16x8 qb4[4];
#pragma unroll
    for (int ks = 0; ks < 4; ks++) qb4[ks] = ld8(sQE + (w * 16 + r16) * LDQ + ks * 32 + quad * 8);
    u16* PM = (u16*)(ws + OFF_PM) + (size_t)item * 4096;
    const int i = w * 16 + r16;
#pragma unroll
    for (int jt = 0; jt < 4; jt++) {
      f32x4 z = (f32x4){0, 0, 0, 0};
#pragma unroll
      for (int ks = 0; ks < 4; ks++) z = MFMA16(ld8(sKE + (jt * 16 + r16) * LDQ + ks * 32 + quad * 8), qb4[ks], z);
#pragma unroll
      for (int e = 0; e < 4; e++) {
        const int j = jt * 16 + quad * 4 + e;
        const bool keep = dir == 0 ? (j <= i) : (j >= i);
        z[e] = keep ? z[e] : 0.f;
      }
      *(uint2*)(PM + i * 64 + jt * 16 + quad * 4) = make_uint2(pack2(z[0], z[1]), pack2(z[2], z[3]));
    }
  }
  {
    u16* QE = (u16*)(ws + OFF_QE) + (size_t)item * 8192;
    u16* KT = (u16*)(ws + OFF_KT) + (size_t)item * 8192;
#pragma unroll
    for (int i = 0; i < 4; i++) {
      const int ch = tid + 256 * i;
      { const int rr = ch >> 4, cc = (ch & 15) * 8; *(uint4*)(QE + rr * 128 + cc) = *(const uint4*)(sQE + rr * LDQ + cc); }
      { const int rr = ch >> 3, cc = (ch & 7) * 8; *(uint4*)(KT + rr * 64 + cc) = *(const uint4*)(sKT + rr * LDT + cc); }
    }
  }
}

__device__ __forceinline__ void gla_scan_item(const Params& p, int l, int item, char* smem) {
  char* ws = p.ws;
  u16* sST = (u16*)smem;
  const int tid = threadIdx.x, lane = tid & 63, w = tid >> 6, r16 = lane & 15, quad = lane >> 4;
  int b, h, dir, dvs, tok0, nch, grp; bool lat;
  if (item < 512) { lat = true; grp = 3 - (item >> 7); const int it = item & 127; b = it >> 5; h = (it >> 3) & 3; dir = (it >> 2) & 1; dvs = it & 3; tok0 = NCTX + b * 1024; nch = 16; }
  else { const int it = item - 512; lat = false; grp = 0; b = it >> 5; h = (it >> 3) & 3; dir = (it >> 2) & 1; dvs = it & 3; tok0 = b * 256; nch = 4; }
  f32x4 ST[8];
  const size_t sbase = ((((size_t)b * 2 + l) * 2 + dir) * 4 + h) * 128;
  if (lat) {
#pragma unroll
    for (int t = 0; t < 8; t++) {
      const float4 v = *(const float4*)(p.state_gla + (sbase + t * 16 + r16) * 256 + dvs * 64 + w * 16 + quad * 4);
      ST[t] = (f32x4){v.x, v.y, v.z, v.w};
    }
  } else {
#pragma unroll
    for (int t = 0; t < 8; t++) ST[t] = (f32x4){0, 0, 0, 0};
  }
  u16* OUTP = (u16*)(ws + (dir == 0 ? OFF_OF : OFF_OB));
  u16* sKT = sST + 64 * LDQ;
  u16* sGV = sKT + 128 * LDT;
  const int lr = tid >> 3, lc = (tid & 7) * 8;
  u32x4 rkt[4], rgv[2];
#define SC_LOAD(CI) { const int c_ = dir == 0 ? (CI) : nch - 1 - (CI); const int cgl = (tok0 >> 6) + c_; \
    const u16* KT_ = (const u16*)(ws + OFF_KT) + (((size_t)cgl * 4 + h) * 2 + dir) * 8192; \
    const u16* GV_ = (const u16*)(ws + OFF_GV) + ((size_t)cgl * 1024 + h * 256 + dvs * 64) * 64; \
    _Pragma("unroll") for (int i = 0; i < 4; i++) rkt[i] = *(const u32x4*)(KT_ + (lr + 32 * i) * 64 + lc); \
    _Pragma("unroll") for (int i = 0; i < 2; i++) rgv[i] = *(const u32x4*)(GV_ + (lr + 32 * i) * 64 + lc); }
  const int nsteps = grp * 4 + 4;
  SC_LOAD(0);
#pragma unroll 1
  for (int ci = 0; ci < nsteps; ci++) {
    const bool full = ci >= grp * 4;
    const int c = dir == 0 ? ci : nch - 1 - ci;
    const int cg_ = (tok0 >> 6) + c;
    const int tb = cg_ * 64;
    const size_t ip = ((size_t)cg_ * 4 + h) * 2 + dir;
    bf16x8 qb4[4], pbf[2];
    if (full) {
      const u16* QE = (const u16*)(ws + OFF_QE) + ip * 8192;
      const u16* PM = (const u16*)(ws + OFF_PM) + ip * 4096;
#pragma unroll
      for (int ks = 0; ks < 4; ks++) qb4[ks] = ld8(QE + (w * 16 + r16) * 128 + ks * 32 + quad * 8);
#pragma unroll
      for (int kh = 0; kh < 2; kh++) pbf[kh] = ld8(PM + (w * 16 + r16) * 64 + kh * 32 + quad * 8);
    }
    const float* EBL = (const float*)(ws + OFF_EBL) + ip * 128;
    float ebl[8];
#pragma unroll
    for (int t = 0; t < 8; t++) ebl[t] = EBL[t * 16 + r16];
    __syncthreads();
#pragma unroll
    for (int i = 0; i < 4; i++) *(u32x4*)(sKT + (lr + 32 * i) * LDT + lc) = rkt[i];
#pragma unroll
    for (int i = 0; i < 2; i++) *(u32x4*)(sGV + (lr + 32 * i) * LDT + lc) = rgv[i];
    if (full) {
#pragma unroll
      for (int t = 0; t < 8; t++)
#pragma unroll
        for (int e = 0; e < 4; e++) sST[(w * 16 + quad * 4 + e) * LDQ + t * 16 + r16] = f2bf(ST[t][e]);
    }
    __syncthreads();
    { const int cn = min(ci + 1, nsteps - 1); SC_LOAD(cn); }
    const bf16x8 vts0 = ld8(sGV + (w * 16 + r16) * LDT + quad * 8), vts1 = ld8(sGV + (w * 16 + r16) * LDT + 32 + quad * 8);
    if (full) {
#pragma unroll
      for (int dt = 0; dt < 4; dt++) {
        f32x4 oacc = (f32x4){0, 0, 0, 0};
#pragma unroll
        for (int kh = 0; kh < 2; kh++) oacc = MFMA16(ld8(sGV + (dt * 16 + r16) * LDT + kh * 32 + quad * 8), pbf[kh], oacc);
#pragma unroll
        for (int ks = 0; ks < 4; ks++) oacc = MFMA16(ld8(sST + (dt * 16 + r16) * LDQ + ks * 32 + quad * 8), qb4[ks], oacc);
        *(uint2*)(OUTP + (size_t)(tb + w * 16 + r16) * 1024 + h * 256 + dvs * 64 + dt * 16 + quad * 4) = make_uint2(pack2(oacc[0], oacc[1]), pack2(oacc[2], oacc[3]));
      }
    }
#pragma unroll
    for (int t = 0; t < 8; t++) {
      f32x4 z = ST[t] * ebl[t];
      z = MFMA16(vts0, ld8(sKT + (t * 16 + r16) * LDT + quad * 8), z);
      z = MFMA16(vts1, ld8(sKT + (t * 16 + r16) * LDT + 32 + quad * 8), z);
      ST[t] = z;
    }
  }
#undef SC_LOAD
  __syncthreads();
  if (!lat) {
#pragma unroll
    for (int t = 0; t < 8; t++)
      *(float4*)(p.out + OUT_S + (sbase + t * 16 + r16) * 256 + dvs * 64 + w * 16 + quad * 4) = make_float4(ST[t][0], ST[t][1], ST[t][2], ST[t][3]);
  }
}

__device__ __forceinline__ void phase_mixa(const Params& p, int l, char* smem) {
  for (int it = blockIdx.x; it < 512 + 1536; it += gridDim.x) {
    if (it < 512) attn_item(p, l, it, smem); else gla_prep_item(p, l, it - 512, smem);
    __syncthreads();
  }
}
__device__ __forceinline__ void phase_mixb(const Params& p, int l, char* smem) {
  unsigned* ctr = (unsigned*)(p.ws + OFF_BAR) + 3600 + 64 * l;
  __shared__ int s_next;
  int it = blockIdx.x;
  for (;;) {
    if (it >= 1536 + 1024) break;
    if (it < 1536) gla_scan_item(p, l, it, smem); else attn_item(p, l, it - 1536 + 512, smem);
    __syncthreads();
    if (threadIdx.x == 0) s_next = (int)gridDim.x + (int)atomicAdd(ctr, 1u);
    __syncthreads();
    it = s_next;
  }
}

__device__ __forceinline__ void phase_glapost(const Params& p, int l) {
  char* ws = p.ws;
  const int lane = threadIdx.x & 63;
  const int wv = blockIdx.x * 4 + (threadIdx.x >> 6), nw = gridDim.x * 4;
  for (int token = wv; token < NTOK; token += nw) {
    const size_t base = (size_t)token * 1024 + lane * 16;
    const uint4 f0 = *(const uint4*)((u16*)(ws + OFF_OF) + base), f1 = *(const uint4*)((u16*)(ws + OFF_OF) + base + 8);
    const uint4 b0 = *(const uint4*)((u16*)(ws + OFF_OB) + base), b1 = *(const uint4*)((u16*)(ws + OFF_OB) + base + 8);
    const uint4 g0 = *(const uint4*)((u16*)(ws + OFF_GOUT) + base), g1 = *(const uint4*)((u16*)(ws + OFF_GOUT) + base + 8);
    const unsigned fu[8] = {f0.x, f0.y, f0.z, f0.w, f1.x, f1.y, f1.z, f1.w};
    const unsigned bu[8] = {b0.x, b0.y, b0.z, b0.w, b1.x, b1.y, b1.z, b1.w};
    const unsigned gu[8] = {g0.x, g0.y, g0.z, g0.w, g1.x, g1.y, g1.z, g1.w};
    float o[16]; float ss = 0;
#pragma unroll
    for (int i = 0; i < 8; i++) {
      o[2 * i] = bf_lo(fu[i]) + bf_lo(bu[i]); o[2 * i + 1] = bf_hi(fu[i]) + bf_hi(bu[i]);
      ss += o[2 * i] * o[2 * i] + o[2 * i + 1] * o[2 * i + 1];
    }
    ss += __shfl_xor(ss, 1); ss += __shfl_xor(ss, 2); ss += __shfl_xor(ss, 4); ss += __shfl_xor(ss, 8);
    const float r = rsqrtf(ss * (1.f / 256.f) + 1e-6f);
    const float* gn = p.gla_norm + l * 256 + (lane & 15) * 16;
    unsigned ou[8];
#pragma unroll
    for (int i = 0; i < 8; i++) {
      const float a = o[2 * i] * r * gn[2 * i] * siluf_(bf_lo(gu[i]));
      const float b = o[2 * i + 1] * r * gn[2 * i + 1] * siluf_(bf_hi(gu[i]));
      ou[i] = pack2(a, b);
    }
    *(uint4*)((u16*)(ws + OFF_OF) + base) = make_uint4(ou[0], ou[1], ou[2], ou[3]);
    *(uint4*)((u16*)(ws + OFF_OF) + base + 8) = make_uint4(ou[4], ou[5], ou[6], ou[7]);
  }
}

__device__ __forceinline__ void phase_gemm_ao(const Params& p, int l, char* smem) {
  char* ws = p.ws;
  u16* sA = (u16*)smem; u16* sB = sA + 128 * LDT; float* sC = (float*)smem;
  const int tid = threadIdx.x, lane = tid & 63, wid = tid >> 6, wr = wid >> 1, wc = wid & 1, r16 = lane & 15, quad = lane >> 4;
  const u16* GM = (const u16*)(ws + OFF_GM);
  for (int q = blockIdx.x >> 3; ; q += gridDim.x >> 3) {
    int mt, nt; if (!xcd_tile(q, 8, mt, nt)) break;
    const int t0 = mt * 128, n0 = nt * 128;
    f32x4 acc[4][4]; acc_zero(acc);
    gemm_tile2(acc, (const u16*)(ws + OFF_ATT) + (size_t)t0 * 1024, 1024, (const u16*)(ws + OFF_WAOT) + ((size_t)l * 1024 + n0) * 1024, 1024, 1024, sA);
    acc_to_lds(acc, sC);
#pragma unroll 2
    for (int i = 0; i < 8; i++) {
      const int id = i * 256 + tid, row = id >> 4, c8 = (id & 15) * 8;
      const u16* gp = GM + (size_t)(t0 + row) * 2048 + n0 + c8;
      const uint4 ga = *(const uint4*)gp, gg = *(const uint4*)(gp + 1024);
      float4* sp = (float4*)(sC + row * LDC + c8);
      float4 a = sp[0], b = sp[1];
      a.x *= bf_lo(ga.x) / bf_lo(gg.x); a.y *= bf_hi(ga.x) / bf_hi(gg.x); a.z *= bf_lo(ga.y) / bf_lo(gg.y); a.w *= bf_hi(ga.y) / bf_hi(gg.y);
      b.x *= bf_lo(ga.z) / bf_lo(gg.z); b.y *= bf_hi(ga.z) / bf_hi(gg.z); b.z *= bf_lo(ga.w) / bf_lo(gg.w); b.w *= bf_hi(ga.w) / bf_hi(gg.w);
      sp[0] = a; sp[1] = b;
    }
    __syncthreads();
#pragma unroll
    for (int i = 0; i < 4; i++)
#pragma unroll
      for (int j = 0; j < 4; j++)
#pragma unroll
        for (int e = 0; e < 4; e++) acc[i][j][e] = sC[(wr * 64 + i * 16 + quad * 4 + e) * LDC + wc * 64 + j * 16 + r16];
    gemm_tile2(acc, (const u16*)(ws + OFF_OF) + (size_t)t0 * 1024, 1024, (const u16*)(ws + OFF_WGOT) + ((size_t)l * 1024 + n0) * 1024, 1024, 1024, sA);
    acc_to_lds(acc, sC);
#pragma unroll 2
    for (int i = 0; i < 8; i++) {
      const int id = i * 256 + tid, row = id >> 4, c8 = (id & 15) * 8, token = t0 + row;
      const uint4 gg = *(const uint4*)(GM + (size_t)token * 2048 + 1024 + n0 + c8);
      const float4 a = *(const float4*)(sC + row * LDC + c8), b = *(const float4*)(sC + row * LDC + c8 + 4);
      *(uint4*)((u16*)(ws + OFF_Q) + (size_t)token * 1024 + n0 + c8) =
          make_uint4(pack2(a.x * bf_lo(gg.x), a.y * bf_hi(gg.x)), pack2(a.z * bf_lo(gg.y), a.w * bf_hi(gg.y)),
                     pack2(b.x * bf_lo(gg.z), b.y * bf_hi(gg.z)), pack2(b.z * bf_lo(gg.w), b.w * bf_hi(gg.w)));
    }
  }
}

__device__ __forceinline__ void phase_gemm_out(const Params& p, int l, char* smem) {
  char* ws = p.ws;
  u16* sA = (u16*)smem; u16* sB = sA + 128 * LDT; float* sC = (float*)smem;
  const int tid = threadIdx.x;
  const float* mod = (const float*)(ws + OFF_MOD) + (size_t)l * 5 * 6144;
  for (int q = blockIdx.x >> 3; ; q += gridDim.x >> 3) {
    int mt, nt; if (!xcd_tile(q, 8, mt, nt)) break;
    const int t0 = mt * 128, n0 = nt * 128;
    f32x4 acc[4][4]; acc_zero(acc);
    gemm_tile2(acc, (const u16*)(ws + OFF_Q) + (size_t)t0 * 1024, 1024, (const u16*)(ws + OFF_WOUT) + ((size_t)l * 1024 + n0) * 1024, 1024, 1024, sA);
    acc_to_lds(acc, sC);
#pragma unroll 4
    for (int i = 0; i < 16; i++) {
      const int id = i * 256 + tid, row = id >> 5, c4 = (id & 31) * 4, token = t0 + row;
      const float4 v = *(const float4*)(sC + row * LDC + c4);
      const f32x4 xv = __builtin_nontemporal_load((const f32x4*)((const float*)(ws + OFF_X) + (size_t)token * 1024 + n0 + c4)); const float4 x = make_float4(xv.x, xv.y, xv.z, xv.w);
      const float4 g = *(const float4*)(mod + (size_t)tok_group(token) * 6144 + 2048 + n0 + c4);
      *(float4*)((float*)(ws + OFF_PRE) + (size_t)token * 1024 + n0 + c4) =
          make_float4(ALPHA * x.x + g.x * v.x, ALPHA * x.y + g.y * v.y, ALPHA * x.z + g.z * v.z, ALPHA * x.w + g.w * v.w);
    }
  }
}

__device__ __forceinline__ void phase_ln1(const Params& p, int l) {
  char* ws = p.ws;
  const int lane = threadIdx.x & 63;
  const int wv = blockIdx.x * 4 + (threadIdx.x >> 6), nw = gridDim.x * 4;
  const float* mod = (const float*)(ws + OFF_MOD) + (size_t)l * 5 * 6144;
  for (int token = wv; token < NTOK; token += nw) {
    float* row = (float*)(ws + OFF_PRE) + (size_t)token * 1024;
    float4 v[4]; float s = 0;
#pragma unroll
    for (int i = 0; i < 4; i++) { const f32x4 t = __builtin_nontemporal_load((const f32x4*)row + i * 64 + lane); v[i] = make_float4(t.x, t.y, t.z, t.w); s += v[i].x + v[i].y + v[i].z + v[i].w; }
    const float mu = wave_sum(s) * (1.f / 1024.f);
    float q = 0;
#pragma unroll
    for (int i = 0; i < 4; i++) { v[i].x -= mu; v[i].y -= mu; v[i].z -= mu; v[i].w -= mu; q += v[i].x * v[i].x + v[i].y * v[i].y + v[i].z * v[i].z + v[i].w * v[i].w; }
    const float rstd = rsqrtf(wave_sum(q) * (1.f / 1024.f) + 1e-5f);
    const float* m = mod + (size_t)tok_group(token) * 6144;
#pragma unroll
    for (int i = 0; i < 4; i++) {
      const int c = i * 256 + lane * 4;
      const float4 g = *(const float4*)(p.ln1_g + l * 1024 + c), bb = *(const float4*)(p.ln1_b + l * 1024 + c);
      float4 x; x.x = v[i].x * rstd * g.x + bb.x; x.y = v[i].y * rstd * g.y + bb.y; x.z = v[i].z * rstd * g.z + bb.z; x.w = v[i].w * rstd * g.w + bb.w;
      ((float4*)row)[i * 64 + lane] = x;
      const float4 sh = *(const float4*)(m + 3072 + c), sc = *(const float4*)(m + 4096 + c);
      *(uint2*)((u16*)(ws + OFF_H) + (size_t)token * 1024 + c) =
          make_uint2(pack2(x.x * (1.f + sc.x) + sh.x, x.y * (1.f + sc.y) + sh.y), pack2(x.z * (1.f + sc.z) + sh.z, x.w * (1.f + sc.w) + sh.w));
    }
  }
}

__device__ __forceinline__ int enc_key(float f) { const int b = __float_as_int(f); return b ^ ((b >> 31) & 0x7fffffff); }
__device__ __forceinline__ float dec_key(int s) { return __int_as_float(s ^ ((s >> 31) & 0x7fffffff)); }
#define CE_DESC(a, b) { const int _mx = max(a, b), _mn = min(a, b); a = _mx; b = _mn; }
__device__ __forceinline__ void sort16_desc(int (&k)[16]) {
#pragma unroll
  for (int size = 2; size <= 16; size <<= 1)
#pragma unroll
    for (int stride = size >> 1; stride > 0; stride >>= 1)
#pragma unroll
      for (int i = 0; i < 16; i++) {
        const int j = i ^ stride;
        if (j > i) { if ((i & size) == 0) { CE_DESC(k[i], k[j]); } else { CE_DESC(k[j], k[i]); } }
      }
}
__device__ __forceinline__ void bitonic_merge16_desc(int (&k)[16]) {
#pragma unroll
  for (int stride = 8; stride > 0; stride >>= 1)
#pragma unroll
    for (int i = 0; i < 16; i++) { const int j = i ^ stride; if (j > i) { CE_DESC(k[i], k[j]); } }
}
__device__ __forceinline__ void merge_top16(int (&a)[16], const int (&b)[16]) {
#pragma unroll
  for (int i = 0; i < 16; i++) a[i] = max(a[i], b[15 - i]);
  bitonic_merge16_desc(a);
}

__device__ __forceinline__ void phase_peerq(const Params& p, int l, char* smem) {
  char* ws = p.ws;
  u16* sA = (u16*)smem; u16* sB = sA + 128 * LDT; float* sC = (float*)smem;
  u16* sQ = (u16*)smem; u16* sS = sQ + 128 * LDQ;
  const int tid = threadIdx.x, lane = tid & 63, wid = tid >> 6, wr = wid >> 1, wc = wid & 1, r16 = lane & 15, quad = lane >> 4;
  int* S1 = (int*)(ws + OFF_S1);
  for (int q = blockIdx.x >> 3; ; q += gridDim.x >> 3) {
    int mt, hd; if (!xcd_tile(q, 8, mt, hd)) break;
    const int t0 = mt * 128;
#pragma unroll 1
    for (int pp = 0; pp < 2; pp++) {
      f32x4 acc[4][4]; acc_zero(acc);
      gemm_tile1(acc, (const u16*)(ws + OFF_H) + (size_t)t0 * 1024, 1024,
                (const u16*)(ws + OFF_WQT) + ((size_t)l * 2048 + hd * 256 + pp * 128) * 1024, 1024, 1024, sA, sB);
      __syncthreads();
#pragma unroll
      for (int i = 0; i < 4; i++)
#pragma unroll
        for (int j = 0; j < 4; j++)
#pragma unroll
          for (int e = 0; e < 4; e++) sQ[(wr * 64 + i * 16 + quad * 4 + e) * LDQ + wc * 64 + j * 16 + r16] = f2bf(acc[i][j][e]);
      {
        const u16* sk = (const u16*)(ws + OFF_SKB) + ((size_t)l * 2 + pp) * 16384;
#pragma unroll
        for (int i = 0; i < 8; i++) {
          const int ch = tid + 256 * i, rr = ch >> 4, cc = (ch & 15) * 8;
          *(uint4*)(sS + rr * LDQ + cc) = *(const uint4*)(sk + rr * 128 + cc);
        }
      }
      __syncthreads();
      acc_zero(acc);
#pragma unroll
      for (int ks = 0; ks < 4; ks++) {
        bf16x8 a[4], b[4];
#pragma unroll
        for (int i = 0; i < 4; i++) a[i] = ld8(sQ + (wr * 64 + i * 16 + r16) * LDQ + ks * 32 + quad * 8);
#pragma unroll
        for (int j = 0; j < 4; j++) b[j] = ld8(sS + (wc * 64 + j * 16 + r16) * LDQ + ks * 32 + quad * 8);
#pragma unroll
        for (int i = 0; i < 4; i++)
#pragma unroll
          for (int j = 0; j < 4; j++) acc[i][j] = MFMA16(a[i], b[j], acc[i][j]);
      }
      acc_to_lds(acc, sC);
#pragma unroll 1
      for (int pass = 0; pass < 4; pass++) {
        const int row = pass * 32 + (tid >> 3), s = tid & 7;
        int k[16];
#pragma unroll
        for (int i = 0; i < 16; i++) { const int col = s + 8 * i; k[i] = (enc_key(sC[row * LDC + col]) & ~127) | col; }
        sort16_desc(k);
#pragma unroll
        for (int m = 1; m <= 4; m <<= 1) {
          int o[16];
#pragma unroll
          for (int i = 0; i < 16; i++) o[i] = __shfl_xor(k[i], m);
          merge_top16(k, o);
        }
        if (s == 0) {
          int4* dst = (int4*)(S1 + (((size_t)(t0 + row) * 8 + hd) * 2 + pp) * 16);
          dst[0] = make_int4(k[0], k[1], k[2], k[3]); dst[1] = make_int4(k[4], k[5], k[6], k[7]);
          dst[2] = make_int4(k[8], k[9], k[10], k[11]); dst[3] = make_int4(k[12], k[13], k[14], k[15]);
        }
      }
    }
    __threadfence_block();
    __syncthreads();
    if (tid < 128) {
      const int token = t0 + tid;
      const int* l1 = S1 + (((size_t)token * 8 + hd) * 2) * 16; const int* l2 = l1 + 16;
      int k1[16], k2[16];
#pragma unroll
      for (int i = 0; i < 4; i++) {
        const int4 a = ((const int4*)l1)[i], b = ((const int4*)l2)[i];
        k1[4 * i] = a.x; k1[4 * i + 1] = a.y; k1[4 * i + 2] = a.z; k1[4 * i + 3] = a.w;
        k2[4 * i] = b.x; k2[4 * i + 1] = b.y; k2[4 * i + 2] = b.z; k2[4 * i + 3] = b.w;
      }
      float v1[16], v2[16];
#pragma unroll
      for (int i = 0; i < 16; i++) { v1[i] = dec_key(k1[i] & ~127); v2[i] = dec_key(k2[i] & ~127); }
#define FILL_GROUP(G, ARR) { int n = 0; _Pragma("unroll") for (int i = 0; i < 16; i++) _Pragma("unroll") for (int j = 0; j < 16; j++) \
        if ((i + 1) * (j + 1) <= 16) { if (n >= (G) * 16 && n < (G) * 16 + 16) ARR[n - (G) * 16] = (enc_key(v1[i] + v2[j]) & ~255) | (i << 4) | j; n++; } \
        _Pragma("unroll") for (int q = 0; q < 16; q++) if ((G) * 16 + q >= 50) ARR[q] = (int)0x80000000; }
      int g0[16], g2[16];
      {
        int g1[16];
        FILL_GROUP(0, g0); sort16_desc(g0);
        FILL_GROUP(1, g1); sort16_desc(g1);
        merge_top16(g0, g1);
      }
      {
        int g3[16];
        FILL_GROUP(2, g2); sort16_desc(g2);
        FILL_GROUP(3, g3); sort16_desc(g3);
        merge_top16(g2, g3);
      }
      merge_top16(g0, g2);
#undef FILL_GROUP
      float sc[16]; float mx = dec_key(g0[0] & ~255), sum = 0;
#pragma unroll
      for (int i = 0; i < 16; i++) { sc[i] = __expf(dec_key(g0[i] & ~255) - mx); sum += sc[i]; }
      const float inv = 1.f / sum;
      int* ei = (int*)(ws + OFF_EI) + (size_t)token * 128 + hd * 16;
      float* eg = (float*)(ws + OFF_EG) + (size_t)token * 128 + hd * 16;
      int eiv[16]; float egv[16];
#pragma unroll
      for (int i = 0; i < 16; i++) {
        const int ci = g0[i] & 255;
        const int i1 = l1[ci >> 4] & 127, i2 = l2[ci & 15] & 127;
        eiv[i] = i1 * 128 + i2;
        egv[i] = sc[i] * inv;
      }
#pragma unroll
      for (int i = 0; i < 4; i++) {
        ((int4*)ei)[i] = make_int4(eiv[4 * i], eiv[4 * i + 1], eiv[4 * i + 2], eiv[4 * i + 3]);
        ((float4*)eg)[i] = make_float4(egv[4 * i], egv[4 * i + 1], egv[4 * i + 2], egv[4 * i + 3]);
      }
    }
    __syncthreads();
  }
}

typedef __attribute__((ext_vector_type(2))) float f32x2v;
#define CV8LO(word) __builtin_amdgcn_cvt_pk_f32_fp8((int)(word), false)
#define CV8HI(word) __builtin_amdgcn_cvt_pk_f32_fp8((int)(word), true)
__device__ __forceinline__ float dot16_fp8(const f32x2v (&hx)[8], const u32x4 r) {
  f32x2v s = CV8LO(r.x) * hx[0];
  s = CV8HI(r.x) * hx[1] + s;
  s = CV8LO(r.y) * hx[2] + s; s = CV8HI(r.y) * hx[3] + s;
  s = CV8LO(r.z) * hx[4] + s; s = CV8HI(r.z) * hx[5] + s;
  s = CV8LO(r.w) * hx[6] + s; s = CV8HI(r.w) * hx[7] + s;
  return s.x + s.y;
}
__device__ __forceinline__ float transpose_reduce64(float (&s)[64], int lane) {
#pragma unroll
  for (int m = 32; m >= 1; m >>= 1) {
    const bool up = (lane & m) != 0;
#pragma unroll
    for (int i = 0; i < m; i++) {
      const float a = s[i], b = s[i + m];
      const float send = up ? a : b, keep = up ? b : a;
      s[i] = keep + __shfl_xor(send, m);
    }
  }
  return s[0];
}
__device__ __forceinline__ void phase_peer_apply(const Params& p, int l) {
  char* ws = p.ws;
  const int lane = threadIdx.x & 63;
  const int wv = blockIdx.x * 4 + (threadIdx.x >> 6), nw = gridDim.x * 4;
  const unsigned char* U = (const unsigned char*)(ws + OFF_U16) + (size_t)l * 16384 * 1024;
  const unsigned char* V = (const unsigned char*)(ws + OFF_V16) + (size_t)l * 16384 * 1024;
  const float* mod = (const float*)(ws + OFF_MOD) + (size_t)l * 5 * 6144;
  for (int token = wv; token < NTOK; token += nw) {
    const u16* hrow = (const u16*)(ws + OFF_H) + (size_t)token * 1024 + lane * 16;
    f32x2v hx[8];
    {
      const uint4 a = *(const uint4*)(hrow), b = *(const uint4*)(hrow + 8);
      hx[0] = (f32x2v){bf_lo(a.x), bf_hi(a.x)}; hx[1] = (f32x2v){bf_lo(a.y), bf_hi(a.y)}; hx[2] = (f32x2v){bf_lo(a.z), bf_hi(a.z)}; hx[3] = (f32x2v){bf_lo(a.w), bf_hi(a.w)};
      hx[4] = (f32x2v){bf_lo(b.x), bf_hi(b.x)}; hx[5] = (f32x2v){bf_lo(b.y), bf_hi(b.y)}; hx[6] = (f32x2v){bf_lo(b.z), bf_hi(b.z)}; hx[7] = (f32x2v){bf_lo(b.w), bf_hi(b.w)};
    }
    const int e0 = ((const int*)(ws + OFF_EI))[(size_t)token * 128 + lane], e1 = ((const int*)(ws + OFF_EI))[(size_t)token * 128 + 64 + lane];
    const float g0 = ((const float*)(ws + OFF_EG))[(size_t)token * 128 + lane], g1 = ((const float*)(ws + OFF_EG))[(size_t)token * 128 + 64 + lane];
    float a0, a1;
    {
      float s[64];
#pragma unroll
      for (int k = 0; k < 64; k++) {
        const int e = __builtin_amdgcn_readlane(e0, k);
        s[k] = dot16_fp8(hx, *(const u32x4*)(U + (size_t)e * 1024 + lane * 16));
      }
      a0 = transpose_reduce64(s, lane) * (1.f / 128.f);
#pragma unroll
      for (int k = 0; k < 64; k++) {
        const int e = __builtin_amdgcn_readlane(e1, k);
        s[k] = dot16_fp8(hx, *(const u32x4*)(U + (size_t)e * 1024 + lane * 16));
      }
      a1 = transpose_reduce64(s, lane) * (1.f / 128.f);
    }
    const float w0 = g0 * geluf_(a0) * (1.f / 16.f), w1 = g1 * geluf_(a1) * (1.f / 16.f);
    f32x2v acc2[8];
#pragma unroll
    for (int i = 0; i < 8; i++) acc2[i] = (f32x2v){0.f, 0.f};
#pragma unroll 8
    for (int k = 0; k < 128; k++) {
      const int e = __builtin_amdgcn_readlane(k < 64 ? e0 : e1, k & 63);
      const float wk = __builtin_bit_cast(float, __builtin_amdgcn_readlane(__builtin_bit_cast(int, k < 64 ? w0 : w1), k & 63));
      const f32x2v wk2 = (f32x2v){wk, wk};
      const u32x4 r = *(const u32x4*)(V + (size_t)e * 1024 + lane * 16);
      acc2[0] = CV8LO(r.x) * wk2 + acc2[0]; acc2[1] = CV8HI(r.x) * wk2 + acc2[1];
      acc2[2] = CV8LO(r.y) * wk2 + acc2[2]; acc2[3] = CV8HI(r.y) * wk2 + acc2[3];
      acc2[4] = CV8LO(r.z) * wk2 + acc2[4]; acc2[5] = CV8HI(r.z) * wk2 + acc2[5];
      acc2[6] = CV8LO(r.w) * wk2 + acc2[6]; acc2[7] = CV8HI(r.w) * wk2 + acc2[7];
    }
    float acc[16];
#pragma unroll
    for (int i = 0; i < 8; i++) { acc[2 * i] = acc2[i].x; acc[2 * i + 1] = acc2[i].y; }
    const float* x1 = (const float*)(ws + OFF_PRE) + (size_t)token * 1024 + lane * 16;
    const float* m = mod + (size_t)tok_group(token) * 6144 + lane * 16;
    float v[16]; float sm = 0;
#pragma unroll
    for (int q = 0; q < 4; q++) {
      const float4 x = *(const float4*)(x1 + q * 4), g = *(const float4*)(m + 5120 + q * 4);
      v[q * 4 + 0] = ALPHA * x.x + g.x * acc[q * 4 + 0]; v[q * 4 + 1] = ALPHA * x.y + g.y * acc[q * 4 + 1];
      v[q * 4 + 2] = ALPHA * x.z + g.z * acc[q * 4 + 2]; v[q * 4 + 3] = ALPHA * x.w + g.w * acc[q * 4 + 3];
    }
#pragma unroll
    for (int i = 0; i < 16; i++) sm += v[i];
    const float mu = wave_sum(sm) * (1.f / 1024.f);
    float q2 = 0;
#pragma unroll
    for (int i = 0; i < 16; i++) { v[i] -= mu; q2 += v[i] * v[i]; }
    const float rstd = rsqrtf(wave_sum(q2) * (1.f / 1024.f) + 1e-5f);
    float* xo = (l == 1 ? p.out + OUT_Y : (float*)(ws + OFF_X)) + (size_t)token * 1024 + lane * 16;
    const float* mn = (const float*)(ws + OFF_MOD) + (size_t)5 * 6144 + (size_t)tok_group(token) * 6144 + lane * 16;
    unsigned hw[8];
#pragma unroll
    for (int q = 0; q < 4; q++) {
      const float4 g = *(const float4*)(p.ln2_g + l * 1024 + lane * 16 + q * 4), bb = *(const float4*)(p.ln2_b + l * 1024 + lane * 16 + q * 4);
      float4 x;
      x.x = v[q * 4 + 0] * rstd * g.x + bb.x; x.y = v[q * 4 + 1] * rstd * g.y + bb.y;
      x.z = v[q * 4 + 2] * rstd * g.z + bb.z; x.w = v[q * 4 + 3] * rstd * g.w + bb.w;
      *(float4*)(xo + q * 4) = x;
      if (l == 0) {
        const float4 sh = *(const float4*)(mn + q * 4), sc = *(const float4*)(mn + 1024 + q * 4);
        hw[q * 2] = pack2(x.x * (1.f + sc.x) + sh.x, x.y * (1.f + sc.y) + sh.y);
        hw[q * 2 + 1] = pack2(x.z * (1.f + sc.z) + sh.z, x.w * (1.f + sc.w) + sh.w);
      }
    }
    if (l == 0) {
      u16* hd = (u16*)(ws + OFF_H) + (size_t)token * 1024 + lane * 16;
      *(uint4*)hd = make_uint4(hw[0], hw[1], hw[2], hw[3]);
      *(uint4*)(hd + 8) = make_uint4(hw[4], hw[5], hw[6], hw[7]);
    }
  }
}

__global__ void __launch_bounds__(256, 2) mega(Params p, int ph_lo, int ph_hi, int coop, int never) {
  extern __shared__ __attribute__((aligned(16))) char smem[];
  __shared__ uint4 xb_words;
  XcdBarrier xb;
  if (coop) {
    if (threadIdx.x == 0) xb_words = make_uint4(0u, 0u, 0u, 0u);
    __syncthreads();
    xb = xcd_barrier_post((unsigned*)(p.ws + OFF_BAR), (volatile LAS unsigned*)&xb_words);
    if (never) cg::this_grid().sync();
  }
#define RUN(PH, CALL) if (ph_lo <= (PH) && (PH) < ph_hi) { CALL; if (coop && (PH) + 1 < ph_hi) xcd_barrier(xb); }
#define LAYER(L) \
  RUN(2 + 9 * L + 0, phase_gemm1(p, L, smem)) \
  RUN(2 + 9 * L + 1, phase_mixa(p, L, smem)) \
  RUN(2 + 9 * L + 2, phase_mixb(p, L, smem)) \
  RUN(2 + 9 * L + 3, phase_glapost(p, L)) \
  RUN(2 + 9 * L + 4, { phase_gemm_ao(p, L, smem); if (L == 0) conv_peer_table(p, 0, 0); else conv_peer_table(p, 1, 1); }) \
  RUN(2 + 9 * L + 5, { phase_gemm_out(p, L, smem); if (L == 0) { conv_peer_table(p, 1, 0); transpose_layer1_idle(p, smem); } }) \
  RUN(2 + 9 * L + 6, phase_ln1(p, L)) \
  RUN(2 + 9 * L + 7, { phase_peerq(p, L, smem); if (L == 0) conv_peer_table(p, 0, 1); }) \
  RUN(2 + 9 * L + 8, phase_peer_apply(p, L))
  RUN(0, phase_prep(p, smem))
  RUN(1, phase_xin(p))
  LAYER(0)
  LAYER(1)
}

constexpr int SMEM_BYTES = 69632;

extern "C" void kernel_launch(void* const* d_in, const int* in_sizes, int n_in, void* d_out, int out_size, void* d_ws, size_t ws_size,
                              hipStream_t stream) {
  static int grid_blocks = 0;
  if (!grid_blocks) {
    hipFuncSetAttribute((const void*)mega, hipFuncAttributeMaxDynamicSharedMemorySize, SMEM_BYTES);
    int dev = 0, cus = 0, per_cu = 0;
    hipGetDevice(&dev);
    hipDeviceGetAttribute(&cus, hipDeviceAttributeMultiprocessorCount, dev);
    hipOccupancyMaxActiveBlocksPerMultiprocessor(&per_cu, mega, 256, SMEM_BYTES);
    if (per_cu > 2) per_cu = 2;
    if (per_cu < 1) per_cu = 1;
    grid_blocks = (cus * per_cu) & ~7;
  }
  if (ws_size < WS_NEED) { fprintf(stderr, "workspace too small: %zu < %zu\n", ws_size, (size_t)WS_NEED); return; }
  Params p{};
  const float** pp = (const float**)&p;
  for (int i = 0; i < 26; i++) pp[i] = (const float*)d_in[i];
  p.out = (float*)d_out;
  p.ws = (char*)d_ws;
  (void)hipMemsetAsync(d_ws, 0, 16384, stream);
  int ph_lo = 0, ph_hi = NPHASE, coop = 1, never = 0;
  void* args[] = {&p, &ph_lo, &ph_hi, &coop, &never};
  hipError_t e = hipLaunchCooperativeKernel((const void*)mega, dim3(grid_blocks), dim3(256), args, SMEM_BYTES, stream);
  if (e != hipSuccess) fprintf(stderr, "cooperative launch failed: %s (grid %d)\n", hipGetErrorString(e), grid_blocks);
}
```
